# Optimizing an MI355X kernel written in HIP

```python
import math
import jax, jax.numpy as jnp
from jax import lax
import numpy as np

D_MODEL = 1024
BATCH = 8
SEQ = 2048
DEPTH = 2

HEAD_DIM = 64
A_HEADS = 4
A_KV_HEADS = 2
B_HEADS = 6
C_HEADS = 6
D_MIX = (A_HEADS + B_HEADS + C_HEADS) * HEAD_DIM
D_FF = 2816
GRID_W = 64
ROPE_THETA = 10000.0
Q_BLOCK = 128
DIL_PAIRS = ((128, 1), (512, 4), (2048, 16))
REL_BUCKETS = 32
REL_MAX_DIST = 1024
CONV_K = 5
CHUNK = 64
NORM_EPS = 1e-6
NEG_INF = -1e30

A_QW = A_HEADS * HEAD_DIM
A_KVW = A_KV_HEADS * HEAD_DIM
B_W = B_HEADS * HEAD_DIM
C_W = C_HEADS * HEAD_DIM
IN_SIZES = (A_QW, A_KVW, A_KVW, B_W, B_W, B_W, C_W, C_W, C_W, C_W, 2 * C_HEADS, 2 * C_HEADS)
N_IN = sum(IN_SIZES)
IN_SPLITS = [int(s) for s in np.cumsum(IN_SIZES)[:-1]]

kernel_name = 'hymba_style_hybrid_encoder'

F32 = jnp.float32


def rms_norm(x, g):
    xf = x.astype(F32)
    y = xf * lax.rsqrt(jnp.mean(xf * xf, axis=-1, keepdims=True) + NORM_EPS)
    return (y * g.astype(F32)).astype(x.dtype)


def l2norm(x):
    return x * lax.rsqrt(jnp.sum(x * x, axis=-1, keepdims=True) + NORM_EPS)


def swiglu(x, wg, wu, wd):
    return (jax.nn.silu(x @ wg) * (x @ wu)) @ wd


def axial_rope(seq):
    rows = seq // GRID_W
    row = jnp.repeat(jnp.arange(rows), GRID_W).astype(F32)
    col = jnp.tile(jnp.arange(GRID_W), rows).astype(F32)
    n_freq = HEAD_DIM // 4
    inv = ROPE_THETA ** (-jnp.arange(n_freq, dtype=F32) / n_freq)
    ang = jnp.concatenate([row[:, None] * inv, col[:, None] * inv], axis=-1)
    return jnp.cos(ang), jnp.sin(ang)


def apply_rope(x, cos, sin):
    xf = x.astype(F32)
    half = HEAD_DIM // 2
    x1, x2 = xf[..., :half], xf[..., half:]
    c, s = cos[None, :, None, :], sin[None, :, None, :]
    return jnp.concatenate([x1 * c - x2 * s, x1 * s + x2 * c], axis=-1).astype(x.dtype)


def dense_gqa(q, k, v):
    B, S, Hq, D = q.shape
    Hkv = k.shape[2]
    G = Hq // Hkv
    nb = S // Q_BLOCK
    qb = q.reshape(B, nb, Q_BLOCK, Hkv, G, D).transpose(1, 0, 2, 3, 4, 5)

    def block(qi):
        s = jnp.einsum('bqhgd,bkhd->bhgqk', qi, k).astype(F32) * (D ** -0.5)
        p = jax.nn.softmax(s, axis=-1)
        return jnp.einsum('bhgqk,bkhd->bqhgd', p.astype(v.dtype), v)

    o = lax.map(block, qb)
    return o.transpose(1, 0, 2, 3, 4, 5).reshape(B, S, Hq * D)


def t5_bucket(rel):
    half = REL_BUCKETS // 2
    exact = half // 2
    sign = jnp.where(rel > 0, half, 0)
    n = jnp.abs(rel)
    nf = jnp.maximum(n, 1).astype(F32)
    large = exact + (jnp.log(nf / exact) / math.log(REL_MAX_DIST / exact) * (half - exact)).astype(jnp.int32)
    large = jnp.minimum(large, half - 1)
    return sign + jnp.where(n < exact, n, large)


def dilated_branch(q, k, v, rel_bias, window, dil):
    B, S, H, D = q.shape
    side = window // (2 * dil)
    blk = side
    L = S // dil
    nb = -(-L // blk)
    Lp = nb * blk

    def to_sub(x):
        x = x.reshape(B, L, dil, H, D).transpose(0, 2, 1, 3, 4)
        return jnp.pad(x, ((0, 0), (0, 0), (0, Lp - L), (0, 0), (0, 0)))

    def windows(x):
        xb = to_sub(x).reshape(B, dil, nb, blk, H, D)
        xb = jnp.pad(xb, ((0, 0), (0, 0), (1, 1), (0, 0), (0, 0), (0, 0)))
        return jnp.concatenate([xb[:, :, :-2], xb[:, :, 1:-1], xb[:, :, 2:]], axis=3)

    qs = to_sub(q).reshape(B, dil, nb, blk, H, D)
    kw, vw = windows(k), windows(v)
    s = jnp.einsum('brnqhd,brnkhd->brnhqk', qs, kw).astype(F32) * (D ** -0.5)
    qi = jnp.arange(blk)
    kj = jnp.arange(3 * blk)
    delta = kj[None, :] - blk - qi[:, None]
    key_sub = jnp.arange(nb)[:, None] * blk - blk + kj[None, :]
    mask = (jnp.abs(delta) <= side)[None] & ((key_sub >= 0) & (key_sub < L))[:, None, :]
    bias = rel_bias[t5_bucket(delta * dil)].astype(F32).transpose(2, 0, 1)
    s = jnp.where(mask[:, None], s + bias, NEG_INF)
    lse = jax.nn.logsumexp(s, axis=-1)
    p = jnp.exp(s - lse[..., None])
    o = jnp.einsum('brnhqk,brnkhd->brnqhd', p.astype(v.dtype), vw)
    o = o.reshape(B, dil, Lp, H, D)[:, :, :L].transpose(0, 2, 1, 3, 4).reshape(B, S, H, D)
    lse = lse.transpose(0, 1, 2, 4, 3).reshape(B, dil, Lp, H)[:, :, :L].transpose(0, 2, 1, 3).reshape(B, S, H)
    return o, lse


def dilated_mixture(q, k, v, rel_bias):
    outs, lses = [], []
    for window, dil in DIL_PAIRS:
        o, l = dilated_branch(q, k, v, rel_bias, window, dil)
        outs.append(o)
        lses.append(l)
    wts = jax.nn.softmax(jnp.stack(lses, axis=-1), axis=-1)
    o = jnp.einsum('bshgd,bshg->bshd', jnp.stack(outs, axis=3), wts.astype(outs[0].dtype))
    B, S, H, D = q.shape
    return o.reshape(B, S, H * D)


def short_conv(x, w):
    K, C = w.shape
    return lax.conv_general_dilated(x, w[:, None, :].astype(x.dtype), window_strides=(1,),
                                    padding=[(K // 2, K // 2)],
                                    dimension_numbers=('NWC', 'WIO', 'NWC'),
                                    feature_group_count=C)


def gated_delta_chunked(q, k, v, g, beta):
    B, H, S, Dk = q.shape
    Dv = v.shape[-1]
    N = S // CHUNK
    qc = q.reshape(B, H, N, CHUNK, Dk)
    kc = k.reshape(B, H, N, CHUNK, Dk)
    vc = v.reshape(B, H, N, CHUNK, Dv)
    gc = jnp.cumsum(g.reshape(B, H, N, CHUNK), axis=-1)
    bc = beta.reshape(B, H, N, CHUNK)
    tril = jnp.tril(jnp.ones((CHUNK, CHUNK), dtype=bool))
    strict = jnp.tril(jnp.ones((CHUNK, CHUNK), dtype=bool), -1)
    diff = gc[..., :, None] - gc[..., None, :]
    decay = jnp.where(tril, jnp.exp(jnp.where(tril, diff, 0.0)), 0.0)
    kb = kc * bc[..., None]
    vb = vc * bc[..., None]
    M = jnp.where(strict, jnp.einsum('bhnid,bhnjd->bhnij', kb, kc) * decay, 0.0)
    eye = jnp.eye(CHUNK, dtype=F32)
    T = lax.linalg.triangular_solve(eye + M, jnp.broadcast_to(eye, M.shape), left_side=True,
                                    lower=True, unit_diagonal=True)
    u = jnp.einsum('bhnij,bhnjv->bhniv', T, vb)
    w = jnp.einsum('bhnij,bhnjk->bhnik', T, kb * jnp.exp(gc)[..., None])
    a_intra = jnp.einsum('bhnid,bhnjd->bhnij', qc, kc) * decay

    def step(state, xs):
        q_i, k_i, u_i, w_i, g_i, a_i = xs
        v_new = u_i - jnp.einsum('bhck,bhkv->bhcv', w_i, state)
        o = (jnp.einsum('bhck,bhkv->bhcv', q_i * jnp.exp(g_i)[..., None], state)
             + jnp.einsum('bhij,bhjv->bhiv', a_i, v_new))
        g_last = g_i[..., -1:]
        state = (state * jnp.exp(g_last)[..., None]
                 + jnp.einsum('bhck,bhcv->bhkv', k_i * jnp.exp(g_last - g_i)[..., None], v_new))
        return state, o

    xs = tuple(jnp.moveaxis(t, 2, 0) for t in (qc, kc, u, w, gc, a_intra))
    state0 = jnp.zeros((B, H, Dk, Dv), F32)
    _, o = lax.scan(step, state0, xs)
    return jnp.moveaxis(o, 0, 2).reshape(B, H, S, Dv)


def gated_deltanet_bidir(cq, ck, cv, cz, cb, ca, conv_w, A_log, dt_bias, out_gain):
    B, S, _ = cq.shape
    qkv = jax.nn.silu(short_conv(jnp.concatenate([cq, ck, cv], axis=-1), conv_w)).astype(F32)
    q, k, v = jnp.split(qkv, 3, axis=-1)

    def heads(t):
        return t.reshape(B, S, C_HEADS, HEAD_DIM).transpose(0, 2, 1, 3)

    q = l2norm(heads(q)) * (HEAD_DIM ** -0.5)
    k = l2norm(heads(k))
    v = heads(v)
    beta = jax.nn.sigmoid(cb.astype(F32)).reshape(B, S, 2, C_HEADS).transpose(2, 0, 3, 1)
    g = (-jnp.exp(A_log.astype(F32))
         * jax.nn.softplus(ca.astype(F32).reshape(B, S, 2, C_HEADS) + dt_bias.astype(F32)))
    g = g.transpose(2, 0, 3, 1)
    flip = lambda t: jnp.flip(t, axis=2)
    qq = jnp.concatenate([q, flip(q)], axis=0)
    kk = jnp.concatenate([k, flip(k)], axis=0)
    vv = jnp.concatenate([v, flip(v)], axis=0)
    gg = jnp.concatenate([g[0], flip(g[1])], axis=0)
    bb = jnp.concatenate([beta[0], flip(beta[1])], axis=0)
    o = gated_delta_chunked(qq, kk, vv, gg, bb)
    o = o[:B] + flip(o[B:])
    o = rms_norm(o, out_gain) * jax.nn.silu(heads(cz.astype(F32)))
    return o.transpose(0, 2, 1, 3).reshape(B, S, C_W).astype(cq.dtype)


def hybrid_mixer(h, rel_bias, w_in, a_qn, a_kn, b_qn, b_kn, c_conv, c_A_log, c_dt_bias, c_out_norm, w_out):
    B, S, _ = h.shape
    proj = h @ w_in
    aq, ak, av, bq, bk, bv, cq, ck, cv, cz, cb, ca = jnp.split(proj, IN_SPLITS, axis=-1)
    cos, sin = axial_rope(S)
    aq = apply_rope(rms_norm(aq.reshape(B, S, A_HEADS, HEAD_DIM), a_qn), cos, sin)
    ak = apply_rope(rms_norm(ak.reshape(B, S, A_KV_HEADS, HEAD_DIM), a_kn), cos, sin)
    av = av.reshape(B, S, A_KV_HEADS, HEAD_DIM)
    out_a = dense_gqa(aq, ak, av)
    bq = rms_norm(bq.reshape(B, S, B_HEADS, HEAD_DIM), b_qn)
    bk = rms_norm(bk.reshape(B, S, B_HEADS, HEAD_DIM), b_kn)
    bv = bv.reshape(B, S, B_HEADS, HEAD_DIM)
    out_b = dilated_mixture(bq, bk, bv, rel_bias).astype(h.dtype)
    out_c = gated_deltanet_bidir(cq, ck, cv, cz, cb, ca, c_conv, c_A_log, c_dt_bias, c_out_norm)
    return jnp.concatenate([out_a, out_b, out_c], axis=-1) @ w_out


def setup_inputs(seed: int = 0) -> dict:
    key = jax.random.key(seed)
    ks = iter(jax.random.split(key, 40))
    L = DEPTH

    def nrm(shape, scale):
        return jax.random.normal(next(ks), shape, F32) * scale

    def gain(shape):
        return 1.0 + 0.02 * jax.random.normal(next(ks), shape, F32)

    x = nrm((BATCH, SEQ, D_MODEL), 1.0)
    rel_bias = nrm((REL_BUCKETS, B_HEADS), 0.5)
    ffn1_norm = gain((L, D_MODEL))
    ffn1_w_gate = nrm((L, D_MODEL, D_FF), D_MODEL ** -0.5)
    ffn1_w_up = nrm((L, D_MODEL, D_FF), D_MODEL ** -0.5)
    ffn1_w_down = nrm((L, D_FF, D_MODEL), D_FF ** -0.5)
    mix_norm = gain((L, D_MODEL))
    w_in = nrm((L, D_MODEL, N_IN), D_MODEL ** -0.5)
    a_q_norm = gain((L, HEAD_DIM))
    a_k_norm = gain((L, HEAD_DIM))
    b_q_norm = gain((L, HEAD_DIM))
    b_k_norm = gain((L, HEAD_DIM))
    c_conv = nrm((L, CONV_K, 3 * C_W), CONV_K ** -0.5)
    c_A_log = jnp.log(jax.random.uniform(next(ks), (L, 2, C_HEADS), F32, 1.0, 16.0))
    dt = jnp.exp(jax.random.uniform(next(ks), (L, 2, C_HEADS), F32, math.log(1e-3), math.log(1e-1)))
    c_dt_bias = dt + jnp.log(-jnp.expm1(-dt))
    c_out_norm = gain((L, HEAD_DIM))
    w_out = nrm((L, D_MIX, D_MODEL), D_MIX ** -0.5)
    ffn2_norm = gain((L, D_MODEL))
    ffn2_w_gate = nrm((L, D_MODEL, D_FF), D_MODEL ** -0.5)
    ffn2_w_up = nrm((L, D_MODEL, D_FF), D_MODEL ** -0.5)
    ffn2_w_down = nrm((L, D_FF, D_MODEL), D_FF ** -0.5)
    return {'x': x, 'rel_bias': rel_bias,
            'ffn1_norm': ffn1_norm, 'ffn1_w_gate': ffn1_w_gate, 'ffn1_w_up': ffn1_w_up, 'ffn1_w_down': ffn1_w_down,
            'mix_norm': mix_norm, 'w_in': w_in,
            'a_q_norm': a_q_norm, 'a_k_norm': a_k_norm, 'b_q_norm': b_q_norm, 'b_k_norm': b_k_norm,
            'c_conv': c_conv, 'c_A_log': c_A_log, 'c_dt_bias': c_dt_bias, 'c_out_norm': c_out_norm,
            'w_out': w_out,
            'ffn2_norm': ffn2_norm, 'ffn2_w_gate': ffn2_w_gate, 'ffn2_w_up': ffn2_w_up, 'ffn2_w_down': ffn2_w_down}


def reference(x, rel_bias, ffn1_norm, ffn1_w_gate, ffn1_w_up, ffn1_w_down, mix_norm, w_in,
              a_q_norm, a_k_norm, b_q_norm, b_k_norm, c_conv, c_A_log, c_dt_bias, c_out_norm,
              w_out, ffn2_norm, ffn2_w_gate, ffn2_w_up, ffn2_w_down):
    h = x
    for l in range(DEPTH):
        h = h + 0.5 * swiglu(rms_norm(h, ffn1_norm[l]), ffn1_w_gate[l], ffn1_w_up[l], ffn1_w_down[l])
        h = h + hybrid_mixer(rms_norm(h, mix_norm[l]), rel_bias, w_in[l], a_q_norm[l], a_k_norm[l],
                             b_q_norm[l], b_k_norm[l], c_conv[l], c_A_log[l], c_dt_bias[l],
                             c_out_norm[l], w_out[l])
        h = h + 0.5 * swiglu(rms_norm(h, ffn2_norm[l]), ffn2_w_gate[l], ffn2_w_up[l], ffn2_w_down[l])
    return h
```

```cpp
#include <hip/hip_runtime.h>
#include <cstdio>
#include <cstdint>
#include <cstring>
constexpr int BATCH = 8, SEQ = 2048, DM = 1024, MT = BATCH * SEQ, DFF = 2816, NIN = 3224, NINP = 3328, NIN_MAIN = 3072, DEPTH = 2;
constexpr int NGU = 2 * DFF;
typedef unsigned short bf16;
typedef unsigned v4u __attribute__((ext_vector_type(4)));
typedef float f32x4 __attribute__((ext_vector_type(4)));
#define LAS __attribute__((address_space(3)))
#define GAS __attribute__((address_space(1)))

constexpr size_t MiB = 1u << 20;
constexpr size_t WS_CTL = 0, CTL_BYTES = 1 * MiB;
constexpr size_t WS_PB = 512 * 1024;
constexpr int PB_AQN = 0, PB_AKN = 64, PB_BQN = 128, PB_BKN = 192, PB_OUTG = 256, PB_ALOG = 320, PB_DTB = 332, PB_REFA = 344, PB_REFB = 345, PB_CONV = 384, PB_LAYER = 6144, PB_REL = 2 * PB_LAYER, PB_TB = PB_REL + 192, PB_FLOATS = PB_TB + 6 * 3 * 136;
constexpr size_t WS_SSQ = 1 * MiB;
constexpr size_t WS_W = 2 * MiB;
constexpr size_t W_GU = (size_t)NGU * DM * 2, W_D = (size_t)DM * DFF * 2, W_IN = (size_t)NINP * DM * 2, W_O = (size_t)DM * DM * 2;
constexpr size_t OFF_GU1 = 0, OFF_D1 = OFF_GU1 + W_GU, OFF_IN = OFF_D1 + W_D, OFF_O = OFF_IN + W_IN, OFF_GU2 = OFF_O + W_O, OFF_D2 = OFF_GU2 + W_GU, W_LAYER = OFF_D2 + W_D;
static_assert(W_LAYER * 2 == 83 * MiB, "weights");
constexpr size_t WS_HB = 85 * MiB;
constexpr size_t WS_R = 117 * MiB;
constexpr size_t WS_HID = WS_R;
constexpr size_t WS_QO = WS_R, WS_KA = WS_QO + 32 * MiB, WS_VA = WS_KA + 4 * MiB, WS_KB = WS_VA + 4 * MiB, WS_VB = WS_KB + 12 * MiB, WS_CR = WS_VB + 12 * MiB,
                 WS_CZ = WS_CR + 36 * MiB, WS_GT = WS_CZ + 12 * MiB, WS_VC = WS_GT + 2 * MiB, WS_CF = WS_VC + 12 * MiB, WS_END = WS_CF + 12 * MiB;
constexpr size_t WS_P0 = WS_CR, WS_P1 = WS_CR + 12 * MiB, WS_P2 = WS_CR + 24 * MiB;
constexpr size_t XS_QN = 0, XS_KN = 12 * MiB, XS_L0 = 24 * MiB, XS_L1 = XS_L0 + 512 * 1024, XS_L2 = XS_L1 + 512 * 1024;
static_assert(WS_END <= 256 * MiB && WS_HID + (size_t)MT * DFF * 2 <= 256 * MiB, "d_ws map");

namespace pg8 {
#define PG8_LAS __attribute__((address_space(3)))
typedef unsigned short bf16_t;
typedef short bf16x8 __attribute__((ext_vector_type(8)));
typedef float f32x4 __attribute__((ext_vector_type(4)));
typedef unsigned u32x4 __attribute__((ext_vector_type(4)));
constexpr int BM = 256, BK = 64, HALF = 128, HTB = HALF * BK * 2  , STAGE_BYTES = 8 * HTB, NXCD = 8, WGM = 8;

__host__ __device__ __forceinline__ int lds_byte(int r, int c) { const int st = (r >> 4) * 2 + (c >> 5), rr = r & 15, cc = c & 31, ob = rr * 64 + cc * 2; return st * 1024 + (ob ^ (((ob >> 9) & 1) << 5)); }
__host__ __device__ __forceinline__ void stage_rc(int b, int& R, int& C) { const int st = b / 1024, sb = b % 1024, swz = sb ^ (((sb >> 9) & 1) << 5); R = (st >> 1) * 16 + swz / 64; C = (st & 1) * 32 + (swz % 64) / 2; }
__host__ __device__ __forceinline__ int perm32(int rho) { const int n = rho >> 4, i = rho & 15; return 8 * (i >> 2) + 4 * n + (i & 3); }

struct Unit { int pm, pn, hm; };
struct Gemm { const bf16_t* A; const bf16_t* Bt; int M, N, K; };

struct StaticOrder {
    int nM, nN, nwg, G, c;
    __host__ __device__ void init(int M, int N, int G_, int c_) { nM = M / BM; nN = N / BM; nwg = nM * nN; G = G_; c = c_; }
    __host__ __device__ bool next(int i, Unit& u) const {
        const long L = (long)i * G + c; if (L >= nwg) return false;
        int wgid = (int)L; { const int q = nwg / NXCD, r = nwg % NXCD, xcd = wgid % NXCD, off = wgid / NXCD; wgid = (xcd < r ? xcd * (q + 1) : r * (q + 1) + (xcd - r) * q) + off; }
        const int nig = WGM * nN, gid = wgid / nig, fm = gid * WGM, gsz = (nM - fm) < WGM ? (nM - fm) : WGM;
        u.pm = fm + ((wgid % nig) % gsz); u.pn = (wgid % nig) / gsz; u.hm = 0; return true;
    }
    __device__ __forceinline__ void a_ready(const Unit&) const {}
    __device__ __forceinline__ void done(const Unit&) const {}
};
struct SplitOrder {
    int nM, nN, nwg, G, c, fullr; bool split, hfirst;
    __host__ __device__ __forceinline__ void init(int M, int N, int G_, int c_) { nM = M / BM; nN = N / BM; nwg = nM * nN; G = G_; c = c_; fullr = nwg / G; split = ((nwg % G) * 2 == G) && (G % (2 * NXCD) == 0) && (nwg % NXCD == 0);
        hfirst = false && split && (((c / NXCD) >> 1) & 1); }
    __host__ __device__ __forceinline__ bool next(int i, Unit& u) const {
        int hm = 0;
        if (split) { if (i > fullr) return false; const int ih = hfirst ? 0 : fullr; if (i == ih) hm = 1 + ((c / NXCD) & 1); else if (hfirst) --i; }
        long L = (long)i * G + c;
        if (hm) L = (long)fullr * G + NXCD * ((c / NXCD) >> 1) + (c % NXCD);
        if (L >= nwg) return false;
        int wgid = (int)L; { const int q = nwg / NXCD, r = nwg % NXCD, xcd = wgid % NXCD, off = wgid / NXCD; wgid = (xcd < r ? xcd * (q + 1) : r * (q + 1) + (xcd - r) * q) + off; }
        const int nig = WGM * nN, gid = wgid / nig, fm = gid * WGM, gsz = (nM - fm) < WGM ? (nM - fm) : WGM;
        u.pm = fm + ((wgid % nig) % gsz); u.pn = (wgid % nig) / gsz; u.hm = hm; return true;
    }
    __device__ __forceinline__ void a_ready(const Unit&) const {}
    __device__ __forceinline__ void done(const Unit&) const {}
};
__device__ __forceinline__ unsigned cvt_pk_bf16(float lo, float hi) { unsigned r; asm volatile("v_cvt_pk_bf16_f32 %0, %1, %2" : "=v"(r) : "v"(lo), "v"(hi)); return r; }
typedef float f32x2 __attribute__((ext_vector_type(2)));
#ifndef PROBE_EPI
#define PROBE_EPI 0
#endif
#ifndef PROBE_EPIX
#define PROBE_EPIX 0
#endif
constexpr float RMS_EPS = 1e-6f;
constexpr int PBL_OFF = 131072 + 6144;
template <class Sched> __device__ __forceinline__ void fill_params(PG8_LAS unsigned char* lds, const float* pbg, int tid) { if (tid < 352) *(PG8_LAS float*)(lds + PBL_OFF + 4 * tid) = pbg[tid]; }
constexpr int RSTD_OFF = 131072;
template <class Sched> __device__ __forceinline__ bool fill_rstd(PG8_LAS unsigned char* lds, const Sched& S, const float* ssq, int tid, int maxu) {
    { Unit u9; if (S.next(maxu, u9)) return false; }
    for (int idx = tid; idx < maxu * 256; idx += 512) { Unit u; if (!S.next(idx >> 8, u)) break;
        const float* p = ssq + (size_t)(u.pm * BM + (idx & 255)) * 16; const f32x4 a = *(const f32x4*)p, b = *(const f32x4*)(p + 4), c = *(const f32x4*)(p + 8), d = *(const f32x4*)(p + 12);
        const float s = (((a[0] + a[1]) + (a[2] + a[3])) + ((b[0] + b[1]) + (b[2] + b[3]))) + (((c[0] + c[1]) + (c[2] + c[3])) + ((d[0] + d[1]) + (d[2] + d[3])));
        *(PG8_LAS float*)(lds + RSTD_OFF + idx * 4) = __builtin_amdgcn_rsqf(s * (1.0f / 1024.0f) + RMS_EPS); }
    __syncthreads();
    return true;
}
__device__ __forceinline__ int pg8_lane_id() { int l; asm volatile("v_mbcnt_lo_u32_b32 %0, -1, 0\n\tv_mbcnt_hi_u32_b32 %0, -1, %0" : "=v"(l)); return l; }
__device__ __forceinline__ float row_rstd(const float* ssq, int row, int fq) {
    const f32x4 p = *(const f32x4*)(ssq + (size_t)row * 16 + 4 * fq);
    float s = (p[0] + p[1]) + (p[2] + p[3]);
    s += __shfl_xor(s, 16); s += __shfl_xor(s, 32);
    return __builtin_amdgcn_rsqf(s * (1.0f / 1024.0f) + RMS_EPS);
}
__device__ __forceinline__ float rstd_of(PG8_LAS unsigned char* lds, const float* ssq, bool tbl, int ui, int lrow, int row, int fq) {
    return tbl ? *(const PG8_LAS float*)(lds + RSTD_OFF + (ui * 256 + lrow) * 4) : row_rstd(ssq, row, fq);
}
__device__ __forceinline__ float silu_f(float x) { return x * __builtin_amdgcn_rcpf(1.0f + __expf(-x)); }

struct EpiSwiGLU {
    static constexpr bool PERM = false, AFTER_DRAIN = false; static constexpr int DUPN = (PROBE_EPI == 1) ? 1 : 0;
    unsigned char* ws; int ldh; int tbl;
    __device__ __forceinline__ void operator()(const f32x4 (&acc)[2][2][4][2], const Unit& u, int wr, int wc, int fr, int fq, int ui, PG8_LAS unsigned char* lds) const {
        asm volatile("" : "+v"(fr), "+v"(fq));
        const int col0 = u.pn * 128 + wc * 32 + 8 * fq;
        const auto hrs = __builtin_amdgcn_make_buffer_rsrc((void*)(ws + WS_HID), 0, MT * DFF * 2, 0x00020000);
        const int hm = u.hm, lr0 = (hm == 2 ? 128 : 0) + wr * (hm ? 32 : 64) + fr, sa = hm ? 64 : 128;
        float rs[2][4];
#pragma unroll
        for (int ai = 0; ai < 2; ++ai)
#pragma unroll
            for (int m = 0; m < 4; ++m) rs[ai][m] = (m < 2 || !hm) ? rstd_of(lds, (const float*)(ws + WS_SSQ), tbl != 0, ui, lr0 + ai * sa + m * 16, u.pm * BM + lr0 + ai * sa + m * 16, fq) : 0.f;
#pragma unroll
        for (int ai = 0; ai < 2; ++ai)
#pragma unroll
            for (int m = 0; m < 4; ++m) if (m < 2 || !hm) {
                const int row = u.pm * BM + lr0 + ai * sa + m * 16;
                const float r = rs[ai][m], nrl = r * -1.4426950408889634f, r2 = r * r;
                f32x4 G0 = acc[ai][0][m][0], G1 = acc[ai][0][m][1], U0 = acc[ai][1][m][0], U1 = acc[ai][1][m][1];
                f32x4 e0 = G0 * nrl, e1 = G1 * nrl;
#pragma unroll
                for (int e = 0; e < 4; ++e) { e0[e] = __builtin_amdgcn_exp2f(e0[e]); e1[e] = __builtin_amdgcn_exp2f(e1[e]); }
                asm volatile("" : "+v"(e0), "+v"(e1));
                f32x4 d0 = e0 + 1.0f, d1 = e1 + 1.0f; const f32x4 p0 = G0 * U0, p1 = G1 * U1;
#pragma unroll
                for (int e = 0; e < 4; ++e) { d0[e] = __builtin_amdgcn_rcpf(d0[e]); d1[e] = __builtin_amdgcn_rcpf(d1[e]); }
                asm volatile("" : "+v"(d0), "+v"(d1));
                const f32x4 h0 = p0 * (d0 * r2), h1 = p1 * (d1 * r2);
                u32x4 w; w.x = cvt_pk_bf16(h0[0], h0[1]); w.y = cvt_pk_bf16(h0[2], h0[3]); w.z = cvt_pk_bf16(h1[0], h1[1]); w.w = cvt_pk_bf16(h1[2], h1[3]);
                __builtin_amdgcn_raw_buffer_store_b128(w, hrs, (unsigned)(row * ldh + col0) * 2u, 0, 16);
                asm volatile("" ::: "memory");
            }
    }
};

struct EpiResid {
    static constexpr bool PERM = false, AFTER_DRAIN = false; static constexpr int DUPN = (PROBE_EPI == 2) ? 1 : 0;
    const float* xin; float* fout; unsigned char* ws; float scale; int pad;
    __device__ __forceinline__ void operator()(const f32x4 (&acc)[2][2][4][2], const Unit& u, int wr, int wc, int fr, int fq, int ui, PG8_LAS unsigned char* lds) const {
        asm volatile("" : "+v"(fr), "+v"(fq));
        const int col0 = u.pn * BM + wc * 32 + 8 * fq; bf16_t* hb = (bf16_t*)(ws + WS_HB); float* ssq = (float*)(ws + WS_SSQ);
        const auto hbrs = __builtin_amdgcn_make_buffer_rsrc((void*)(ws + WS_HB), 0, MT * 1024 * 2, 0x00020000);
        const auto finish = [&](int ai, int m, const f32x4 (&h0)[2], const f32x4 (&h1)[2]) {
            const int row = u.pm * BM + ai * HALF + wr * 64 + m * 16 + fr;
            float ss = 0.f;
#pragma unroll
            for (int bj = 0; bj < 2; ++bj) {
                const size_t off = (size_t)row * 1024 + col0 + bj * HALF;
                const f32x4 o0 = h0[bj] + acc[ai][bj][m][0] * scale, o1 = h1[bj] + acc[ai][bj][m][1] * scale;
                if (fout) { *(f32x4*)(fout + off) = o0; *(f32x4*)(fout + off + 4) = o1; }
                else {
                    u32x4 w; w.x = cvt_pk_bf16(o0[0], o0[1]); w.y = cvt_pk_bf16(o0[2], o0[3]); w.z = cvt_pk_bf16(o1[0], o1[1]); w.w = cvt_pk_bf16(o1[2], o1[3]);
                    __builtin_amdgcn_raw_buffer_store_b128(w, hbrs, (unsigned)off * 2u, 0, 16);
                    ss += (o0[0] * o0[0] + o0[1] * o0[1]) + (o0[2] * o0[2] + o0[3] * o0[3]) + (o1[0] * o1[0] + o1[1] * o1[1]) + (o1[2] * o1[2] + o1[3] * o1[3]);
                }
            }
            if (!fout) { ss += __shfl_xor(ss, 16); ss += __shfl_xor(ss, 32); if (fq == 0) ssq[(size_t)row * 16 + u.pn * 4 + wc] = ss; }
        };
        if (xin) {
#pragma unroll
            for (int ai = 0; ai < 2; ++ai) {
                f32x4 pre[4][2][2];
#pragma unroll
                for (int m = 0; m < 4; ++m)
#pragma unroll
                    for (int bj = 0; bj < 2; ++bj) { const size_t off = (size_t)(u.pm * BM + ai * HALF + wr * 64 + m * 16 + fr) * 1024 + col0 + bj * HALF; pre[m][bj][0] = *(const f32x4*)(xin + off); pre[m][bj][1] = *(const f32x4*)(xin + off + 4); }
#pragma unroll
                for (int m = 0; m < 4; ++m) { const f32x4 h0[2] = {pre[m][0][0], pre[m][1][0]}, h1[2] = {pre[m][0][1], pre[m][1][1]}; finish(ai, m, h0, h1); }
                asm volatile("" ::: "memory");
            }
        } else {
            u32x4 praw[2][4][2];
#pragma unroll
            for (int ai = 0; ai < 2; ++ai)
#pragma unroll
                for (int m = 0; m < 4; ++m)
#pragma unroll
                    for (int bj = 0; bj < 2; ++bj) praw[ai][m][bj] = *(const u32x4*)(hb + (size_t)(u.pm * BM + ai * HALF + wr * 64 + m * 16 + fr) * 1024 + col0 + bj * HALF);
#pragma unroll
            for (int ai = 0; ai < 2; ++ai)
#pragma unroll
                for (int m = 0; m < 4; ++m) {
                    f32x4 h0[2], h1[2];
#pragma unroll
                    for (int bj = 0; bj < 2; ++bj) { const u32x4 w = praw[ai][m][bj];
                        h0[bj] = (f32x4){__builtin_bit_cast(float, w.x << 16), __builtin_bit_cast(float, w.x & 0xffff0000u), __builtin_bit_cast(float, w.y << 16), __builtin_bit_cast(float, w.y & 0xffff0000u)};
                        h1[bj] = (f32x4){__builtin_bit_cast(float, w.z << 16), __builtin_bit_cast(float, w.z & 0xffff0000u), __builtin_bit_cast(float, w.w << 16), __builtin_bit_cast(float, w.w & 0xffff0000u)}; }
                    finish(ai, m, h0, h1);
                    asm volatile("" ::: "memory");
                }
        }
    }
};

constexpr float ATT_C2 = 0.125f * 1.4426950408889634f;
struct EpiInProj {
    static constexpr bool PERM = false, AFTER_DRAIN = false; static constexpr int DUPN = (PROBE_EPI == 3) ? 1 : 0;
    unsigned char* ws; int layer; int hs_off; int tbl;
    __device__ __forceinline__ void operator()(const f32x4 (&acc)[2][2][4][2], const Unit& u, int wr, int wc, int fr, int fq, int ui, PG8_LAS unsigned char* lds) const {
        asm volatile("" : "+v"(fr), "+v"(fq));
        const int dp = ui >> 16; ui &= 0xffff; const bool st_en = !(PROBE_EPI == 3 && ((PROBE_EPIX == 1 && dp == 1) || (PROBE_EPIX == 6 && dp == 0)) && ((const volatile unsigned*)(ws + WS_CTL))[64] == 0u);
        if (PROBE_EPI == 3 && PROBE_EPIX >= 2 && PROBE_EPIX <= 5 && dp == 1) { const int pn_ = u.pn + (hs_off >> 2); const bool sel = PROBE_EPIX == 2 ? pn_ == 11 : (PROBE_EPIX == 3 ? pn_ < 2 : (PROBE_EPIX == 4 ? (pn_ >= 2 && pn_ < 5) : (pn_ >= 5 && pn_ < 11))); if (!sel) return; }
        const int hs = u.pn * 4 + wc + hs_off;
        if (hs >= 51) return;
        const float* ssq = (const float*)(ws + WS_SSQ); const PG8_LAS float* pb = (const PG8_LAS float*)(lds + PBL_OFF);
        if (hs == 44) {
            f32x4 al0, al1, db0, db1;
#pragma unroll
            for (int j = 0; j < 8; ++j) { const int d = 8 * fq + j - 12; const bool v = (d >= 0 && d < 12); const float a_ = v ? -__expf(pb[PB_ALOG + (v ? d : 0)]) : 0.f, b_ = v ? pb[PB_DTB + (v ? d : 0)] : 0.f;
                if (j < 4) { al0[j] = a_; db0[j] = b_; } else { al1[j - 4] = a_; db1[j - 4] = b_; } }
#pragma unroll
            for (int ai = 0; ai < 2; ++ai)
#pragma unroll
                for (int m = 0; m < 4; ++m) {
                    const int row = u.pm * BM + ai * HALF + wr * 64 + m * 16 + fr;
                    const float r = rstd_of(lds, ssq, tbl != 0, ui, ai * HALF + wr * 64 + m * 16 + fr, row, fq);
                    const f32x4 z0 = acc[ai][0][m][0] * r + db0, z1 = acc[ai][0][m][1] * r + db1;
                    f32x4 t0, t1;
#pragma unroll
                    for (int e = 0; e < 4; ++e) { t0[e] = __builtin_amdgcn_exp2f(fabsf(z0[e]) * -1.4426950408889634f); t1[e] = __builtin_amdgcn_exp2f(fabsf(z1[e]) * -1.4426950408889634f); }
                    asm volatile("" : "+v"(t0), "+v"(t1));
                    const f32x4 d0 = t0 + 1.0f, d1 = t1 + 1.0f;
                    f32x4 rc0, rc1, lg0, lg1;
#pragma unroll
                    for (int e = 0; e < 4; ++e) { rc0[e] = __builtin_amdgcn_rcpf(d0[e]); rc1[e] = __builtin_amdgcn_rcpf(d1[e]); }
#pragma unroll
                    for (int e = 0; e < 4; ++e) { lg0[e] = __builtin_amdgcn_logf(d0[e]); lg1[e] = __builtin_amdgcn_logf(d1[e]); }
                    asm volatile("" : "+v"(rc0), "+v"(rc1), "+v"(lg0), "+v"(lg1));
                    f32x4 o0, o1;
#pragma unroll
                    for (int e = 0; e < 4; ++e) {
                        const float sg0 = (z0[e] >= 0.f ? 1.0f : t0[e]) * rc0[e], sg1 = (z1[e] >= 0.f ? 1.0f : t1[e]) * rc1[e];
                        const float sp0 = fmaxf(z0[e], 0.f) + lg0[e] * 0.6931471805599453f, sp1 = fmaxf(z1[e], 0.f) + lg1[e] * 0.6931471805599453f;
                        o0[e] = (8 * fq + e < 12) ? sg0 : al0[e] * sp0; o1[e] = (8 * fq + 4 + e < 12) ? sg1 : al1[e] * sp1;
                    }
                    float* gp = (float*)(ws + WS_GT) + (size_t)row * 32 + 8 * fq;
                    *(f32x4*)gp = o0; *(f32x4*)(gp + 4) = o1;
                    asm volatile("" ::: "memory");
                }
            return;
        }
        bf16_t* dst; int ld; const PG8_LAS float* gain = nullptr; bool rope = false, dosilu = false; float sc = 1.f;
        if (hs < 4)       { dst = (bf16_t*)(ws + WS_QO) + 64 * hs;              ld = 1024; gain = pb + PB_AQN; rope = true; sc = ATT_C2; }
        else if (hs < 6)  { dst = (bf16_t*)(ws + WS_KA) + 64 * (hs - 4);        ld = 128;  gain = pb + PB_AKN; rope = true; }
        else if (hs < 8)  { dst = (bf16_t*)(ws + WS_VA) + 64 * (hs - 6);        ld = 128; }
        else if (hs < 14) { dst = (bf16_t*)(ws + WS_QO) + 256 + 64 * (hs - 8);  ld = 1024; gain = pb + PB_BQN; sc = ATT_C2; }
        else if (hs < 20) { dst = (bf16_t*)(ws + WS_KB) + 64 * (hs - 14);       ld = 384;  gain = pb + PB_BKN; }
        else if (hs < 26) { dst = (bf16_t*)(ws + WS_VB) + 64 * (hs - 20);       ld = 384; }
        else if (hs < 44) { dst = (bf16_t*)(ws + WS_CR) + 64 * (hs - 26);       ld = 1152; }
        else              { dst = (bf16_t*)(ws + WS_CZ) + 64 * (hs - 45);       ld = 384;  dosilu = true; }
        const auto drs = __builtin_amdgcn_make_buffer_rsrc((void*)dst, 0, 0x7fffffff, 0x00020000);
        float g0[8], g1[8];
#pragma unroll
        for (int j = 0; j < 8; ++j) { g0[j] = gain ? gain[8 * fq + j] * sc : sc; g1[j] = gain ? gain[32 + 8 * fq + j] * sc : sc; }
        float inv[8];
#pragma unroll
        for (int j = 0; j < 8; ++j) inv[j] = rope ? __builtin_amdgcn_exp2f(-(float)(8 * (fq & 1) + j) * (13.287712379549449f / 16.0f)) : 0.f;
#pragma unroll
        for (int ai = 0; ai < 2; ++ai) {
            float rs[4];
#pragma unroll
            for (int m = 0; m < 4; ++m) rs[m] = rstd_of(lds, ssq, tbl != 0, ui, ai * HALF + wr * 64 + m * 16 + fr, u.pm * BM + ai * HALF + wr * 64 + m * 16 + fr, fq);
#pragma unroll
            for (int m = 0; m < 4; ++m) {
                const int row = u.pm * BM + ai * HALF + wr * 64 + m * 16 + fr;
                const float r = rs[m];
                float v0[8], v1[8];
#pragma unroll
                for (int j = 0; j < 8; ++j) { v0[j] = acc[ai][0][m][j >> 2][j & 3] * r; v1[j] = acc[ai][1][m][j >> 2][j & 3] * r; }
                float rn = 1.f;
                if (gain) {
                    float ss = 0.f;
#pragma unroll
                    for (int j = 0; j < 8; ++j) ss += v0[j] * v0[j] + v1[j] * v1[j];
                    ss += __shfl_xor(ss, 16); ss += __shfl_xor(ss, 32);
                    rn = __builtin_amdgcn_rsqf(ss * (1.0f / 64.0f) + RMS_EPS);
                }
#pragma unroll
                for (int j = 0; j < 8; ++j) { v0[j] *= rn * g0[j]; v1[j] *= rn * g1[j]; }
                if (rope) {
                    const int t = row & 2047; const float pos = (float)((fq < 2) ? (t >> 6) : (t & 63));
#pragma unroll
                    for (int j = 0; j < 8; ++j) { const float ang = pos * inv[j];
                        const float c = __cosf(ang), s = __sinf(ang); const float x1 = v0[j], x2 = v1[j]; v0[j] = x1 * c - x2 * s; v1[j] = x1 * s + x2 * c; }
                }
                if (dosilu) {
#pragma unroll
                    for (int j = 0; j < 8; ++j) { v0[j] = silu_f(v0[j]); v1[j] = silu_f(v1[j]); }
                }
                const unsigned po = (unsigned)(row * ld + 8 * fq) * 2u;
                u32x4 w; w.x = cvt_pk_bf16(v0[0], v0[1]); w.y = cvt_pk_bf16(v0[2], v0[3]); w.z = cvt_pk_bf16(v0[4], v0[5]); w.w = cvt_pk_bf16(v0[6], v0[7]);
                if (st_en) __builtin_amdgcn_raw_buffer_store_b128(w, drs, po, 0, 16); else asm volatile("" :: "v"(w));
                w.x = cvt_pk_bf16(v1[0], v1[1]); w.y = cvt_pk_bf16(v1[2], v1[3]); w.z = cvt_pk_bf16(v1[4], v1[5]); w.w = cvt_pk_bf16(v1[6], v1[7]);
                if (st_en) __builtin_amdgcn_raw_buffer_store_b128(w, drs, po + 64u, 0, 16); else asm volatile("" :: "v"(w));
                asm volatile("" ::: "memory");
            }
        }
    }
};
template <class Epi, class Sched, bool ALIGN_EPI = false, bool SP2 = false, bool HALFCAP = false>
__device__ __forceinline__ void gemm_phase(PG8_LAS unsigned char* lds, const Gemm g, const Sched& S, const Epi& E, int tid_) {
    asm volatile("" : "+v"(tid_)); const int tid = tid_, wid = __builtin_amdgcn_readfirstlane(tid >> 6), lane = tid & 63, wr = wid >> 2, wc = wid & 3, fr = lane & 15, fq = lane >> 4;
    const int K = g.K, nt = K / BK;
    unsigned voffA[2], voffB[2];
#pragma unroll
    for (int i = 0; i < 2; ++i) { int R, C; stage_rc(tid * 16 + i * 8192, R, C); const int Rb = Epi::PERM ? ((R & ~31) + perm32(R & 31)) : R;
        voffA[i] = (unsigned)(R * K + C) * 2u; voffB[i] = (unsigned)(Rb * K + C) * 2u; }
    const size_t kstep = (size_t)(BK * 2);
    const size_t hstep = (size_t)HALF * K * 2;
    const size_t tstep = 2 * hstep;
    const unsigned ldsw = (unsigned)wid * 1024u;
    int aoff = lds_byte(wr * 64 + fr, fq * 8); const int boff = lds_byte(wc * 32 + fr, fq * 8);
#define PG8_SA(b, h) (((b) * 2 + (h)) * HTB)
#define PG8_SB(b, h) ((4 + (b) * 2 + (h)) * HTB)
#define PG8_STAGE(bufoff, gbase, voff) do { _Pragma("unroll") for (int _i = 0; _i < 2; ++_i) \
        __builtin_amdgcn_global_load_lds((const unsigned*)((const char*)(gbase) + (voff)[_i]), (PG8_LAS unsigned*)(lds + (bufoff) + ldsw + _i * 8192), 16, 0, 0); } while (0)
#define PG8_STAGEA(bufoff, gbase) do { _Pragma("unroll") for (int _i = 0; _i < NPA; ++_i) \
        __builtin_amdgcn_global_load_lds((const unsigned*)((const char*)(gbase) + voffA[_i]), (PG8_LAS unsigned*)(lds + (bufoff) + ldsw + _i * 8192), 16, 0, 0); } while (0)
#define PG8_STAGEA_N(bufoff, gbase, trc) do { _Pragma("unroll") for (int _i = 0; _i < 2; ++_i) if (_i < NPA || (trc)) \
        __builtin_amdgcn_global_load_lds((const unsigned*)((const char*)(gbase) + voffA[_i]), (PG8_LAS unsigned*)(lds + (bufoff) + ldsw + _i * 8192), 16, 0, 0); } while (0)
#define PG8_WAIT_SEL(trc, a, b) do { if (trc) PG8_WAIT_V(a); else PG8_WAIT_V(b); } while (0)
#define PG8_LDA(dst, b, h) do { _Pragma("unroll") for (int m = 0; m < MFR; ++m) _Pragma("unroll") for (int k = 0; k < 2; ++k) dst[m][k] = *(const PG8_LAS bf16x8*)(lds + PG8_SA(b, h) + aoff + m * 2048 + k * 1024); } while (0)
#define PG8_LDB(dst, b, h) do { _Pragma("unroll") for (int n = 0; n < 2; ++n) _Pragma("unroll") for (int k = 0; k < 2; ++k) dst[n][k] = *(const PG8_LAS bf16x8*)(lds + PG8_SB(b, h) + boff + n * 2048 + k * 1024); } while (0)
#define PG8_MMA(ai, bj, At, Bt) do { __builtin_amdgcn_s_setprio(1); _Pragma("unroll") for (int m = 0; m < MFR; ++m) _Pragma("unroll") for (int n = 0; n < 2; ++n) _Pragma("unroll") for (int k = 0; k < 2; ++k) \
        acc[ai][bj][m][n] = __builtin_amdgcn_mfma_f32_16x16x32_bf16(Bt[n][k], At[m][k], acc[ai][bj][m][n], 0, 0, 0); __builtin_amdgcn_s_setprio(0); } while (0)
#define PG8_WAIT_V(n) asm volatile("s_waitcnt vmcnt(" #n ")" ::: "memory")
#define PG8_WAIT_L(n) asm volatile("s_waitcnt lgkmcnt(" #n ")" ::: "memory")
#define PG8_BAR __builtin_amdgcn_s_barrier()
#define PG8_SCHED __builtin_amdgcn_sched_barrier(0)
    Unit cur, nxt; int ui = 0;
    if (!S.next(0, cur)) return;
    static_assert(!HALFCAP || SP2, "half units: SP2 loop only");
    f32x4 acc[2][2][4][2];
#pragma unroll
    for (int a = 0; a < 2; ++a)
#pragma unroll
        for (int b = 0; b < 2; ++b)
#pragma unroll
            for (int m = 0; m < 4; ++m)
#pragma unroll
                for (int n = 0; n < 2; ++n) acc[a][b][m][n] = (f32x4){0.f, 0.f, 0.f, 0.f};
    bf16x8 At[4][2], B0[2][2], B1[2][2];
    const char* cA = (const char*)g.A + (size_t)cur.pm * tstep; const char* cB = (const char*)g.Bt + (size_t)cur.pn * tstep;
    size_t ahs = hstep;
    if constexpr (HALFCAP) { if (cur.hm) { if (cur.hm == 2) cA += hstep; ahs = hstep >> 1; aoff = lds_byte(wr * 32 + fr, fq * 8); } }
    S.a_ready(cur);
    {   constexpr int NPA = 2;
    if constexpr (SP2) {
        PG8_STAGE(PG8_SB(0, 0), cB, voffB); PG8_STAGE(PG8_SB(0, 1), cB + hstep, voffB); PG8_STAGEA(PG8_SA(0, 0), cA); PG8_STAGEA(PG8_SA(0, 1), cA + ahs);
        if (wr == 1) PG8_BAR;
        PG8_WAIT_V(2); PG8_BAR;
        PG8_STAGE(PG8_SB(1, 0), cB + kstep, voffB); PG8_STAGEA(PG8_SA(1, 0), cA + kstep); PG8_STAGE(PG8_SB(1, 1), cB + hstep + kstep, voffB);
        PG8_WAIT_V(6); PG8_BAR;
    } else {
        PG8_STAGE(PG8_SB(0, 0), cB, voffB); PG8_STAGE(PG8_SA(0, 0), cA, voffA); PG8_STAGE(PG8_SB(0, 1), cB + hstep, voffB); PG8_STAGE(PG8_SA(0, 1), cA + hstep, voffA);
        if (wr == 1) PG8_BAR;
        PG8_WAIT_V(4); PG8_BAR;
        PG8_STAGE(PG8_SB(1, 0), cB + kstep, voffB); PG8_STAGE(PG8_SA(1, 0), cA + kstep, voffA); PG8_STAGE(PG8_SB(1, 1), cB + hstep + kstep, voffB);
        PG8_WAIT_V(6); PG8_BAR;
    }
    }
#define PG8_KLOOP(WV, TRX) \
        for (int t = 0; t < nt; t += 2) { \
            const bool last = (t == nt - 2); \
            const bool trc = last && (TRX);            \
            const char* a1 = cA + (size_t)(t + 1) * kstep; \
            const char* a2 = last ? nA : cA + (size_t)(t + 2) * kstep; const char* b2 = last ? nB : cB + (size_t)(t + 2) * kstep; \
            const char* a3 = a2 + kstep; const char* b3 = b2 + kstep; \
            const size_t ah2 = last ? nahs : ahs; \
            if (last && has_next) S.a_ready(nxt); \
            PG8_LDB(B0, 0, 0); PG8_LDB(B1, 0, 1); PG8_SCHED; PG8_LDA(At, 0, 0); PG8_STAGEA(PG8_SA(1, 1), a1 + ahs); \
            PG8_WAIT_V(WV); PG8_WAIT_L(0); PG8_BAR; PG8_MMA(0, 0, At, B0); PG8_MMA(0, 1, At, B1); PG8_BAR; PG8_SCHED; \
            PG8_LDA(At, 0, 1); PG8_STAGE(PG8_SB(0, 0), b2, voffB); PG8_STAGE(PG8_SB(0, 1), b2 + hstep, voffB); PG8_STAGEA_N(PG8_SA(0, 0), a2, trc); \
            PG8_WAIT_SEL(trc, 7, WV); PG8_WAIT_L(0); PG8_BAR; PG8_MMA(1, 0, At, B0); PG8_MMA(1, 1, At, B1); PG8_BAR; PG8_SCHED; \
            PG8_LDB(B0, 1, 0); PG8_LDB(B1, 1, 1); PG8_SCHED; PG8_LDA(At, 1, 0); PG8_STAGEA_N(PG8_SA(0, 1), a2 + ah2, trc); \
            PG8_WAIT_SEL(trc, 8, WV); PG8_WAIT_L(0); PG8_BAR; PG8_MMA(0, 0, At, B0); PG8_MMA(0, 1, At, B1); PG8_BAR; PG8_SCHED; \
            PG8_LDA(At, 1, 1); PG8_STAGE(PG8_SB(1, 0), b3, voffB); PG8_STAGE(PG8_SB(1, 1), b3 + hstep, voffB); PG8_STAGEA_N(PG8_SA(1, 0), a3, trc); \
            PG8_WAIT_SEL(trc, 8, WV); PG8_WAIT_L(0); PG8_BAR; PG8_MMA(1, 0, At, B0); PG8_MMA(1, 1, At, B1); PG8_BAR; PG8_SCHED; \
        }
    for (;;) {
        const bool has_next = S.next(ui + 1, nxt);
        const char* nA = has_next ? (const char*)g.A + (size_t)nxt.pm * tstep : cA; const char* nB = has_next ? (const char*)g.Bt + (size_t)nxt.pn * tstep : cB;
        size_t nahs = has_next ? hstep : ahs;
        if constexpr (HALFCAP) { if (has_next && nxt.hm) { if (nxt.hm == 2) nA += hstep; nahs = hstep >> 1; } }
        if constexpr (SP2) {
            if constexpr (HALFCAP) {
                if (cur.hm) { constexpr int MFR = 2, NPA = 1; const bool nfull = has_next && !nxt.hm; PG8_KLOOP(6, nfull) }
                else { constexpr int MFR = 4, NPA = 2; PG8_KLOOP(8, false) }
            } else { constexpr int MFR = 4, NPA = 2; PG8_KLOOP(8, false) }
        } else {
        constexpr int MFR = 4;
        for (int t = 0; t < nt; t += 2) {
            const bool last = (t == nt - 2);
            const char* a1 = cA + (size_t)(t + 1) * kstep;
            const char* a2 = last ? nA : cA + (size_t)(t + 2) * kstep; const char* b2 = last ? nB : cB + (size_t)(t + 2) * kstep;
            const char* a3 = a2 + kstep; const char* b3 = b2 + kstep;
            if (last && has_next) S.a_ready(nxt);
            PG8_LDB(B0, 0, 0); PG8_SCHED; PG8_LDA(At, 0, 0); PG8_STAGE(PG8_SA(1, 1), a1 + hstep, voffA);
            PG8_WAIT_L(8); PG8_BAR; PG8_WAIT_L(0); PG8_MMA(0, 0, At, B0); PG8_BAR; PG8_SCHED;
            PG8_LDB(B1, 0, 1); PG8_STAGE(PG8_SB(0, 0), b2, voffB);
            PG8_BAR; PG8_WAIT_L(0); PG8_MMA(0, 1, At, B1); PG8_BAR;
            PG8_LDA(At, 0, 1); PG8_STAGE(PG8_SA(0, 0), a2, voffA);
            PG8_BAR; PG8_WAIT_L(0); PG8_MMA(1, 0, At, B0); PG8_BAR; PG8_SCHED;
            PG8_STAGE(PG8_SB(0, 1), b2 + hstep, voffB);
            PG8_WAIT_V(6); PG8_BAR; PG8_MMA(1, 1, At, B1); PG8_BAR;
            PG8_LDB(B0, 1, 0); PG8_SCHED; PG8_LDA(At, 1, 0); PG8_STAGE(PG8_SA(0, 1), a2 + hstep, voffA);
            PG8_WAIT_L(8); PG8_BAR; PG8_WAIT_L(0); PG8_MMA(0, 0, At, B0); PG8_BAR; PG8_SCHED;
            PG8_LDB(B1, 1, 1); PG8_STAGE(PG8_SB(1, 0), b3, voffB);
            PG8_BAR; PG8_WAIT_L(0); PG8_MMA(0, 1, At, B1); PG8_BAR;
            PG8_LDA(At, 1, 1); PG8_STAGE(PG8_SA(1, 0), a3, voffA);
            PG8_BAR; PG8_WAIT_L(0); PG8_MMA(1, 0, At, B0); PG8_BAR; PG8_SCHED;
            PG8_STAGE(PG8_SB(1, 1), b3 + hstep, voffB);
            PG8_WAIT_V(6); PG8_BAR; PG8_MMA(1, 1, At, B1); PG8_BAR;
        }
        }
        if constexpr (ALIGN_EPI) { if (wr == 0) PG8_BAR; }
        if constexpr (!Epi::AFTER_DRAIN) { _Pragma("unroll 1") for (int dp_ = 0; dp_ <= Epi::DUPN; ++dp_) { const int le_ = pg8_lane_id(); E(acc, cur, wr, wc, le_ & 15, le_ >> 4, ui | (dp_ << 16), lds); } S.done(cur); }
        if (!has_next) break;
#pragma unroll
        for (int a = 0; a < 2; ++a)
#pragma unroll
            for (int b = 0; b < 2; ++b)
#pragma unroll
                for (int m = 0; m < 4; ++m)
#pragma unroll
                    for (int n = 0; n < 2; ++n) acc[a][b][m][n] = (f32x4){0.f, 0.f, 0.f, 0.f};
        cur = nxt; cA = nA; cB = nB; ahs = nahs; ++ui;
        if constexpr (HALFCAP) { const int le_ = pg8_lane_id(); aoff = lds_byte((cur.hm ? wr * 32 : wr * 64) + (le_ & 15), (le_ >> 4) * 8); }
        if constexpr (ALIGN_EPI) { if (wr == 1) PG8_BAR; }
    }
    PG8_WAIT_V(0);
    if constexpr (!ALIGN_EPI) { if (wr == 0) PG8_BAR; }
    PG8_BAR;
    if constexpr (Epi::AFTER_DRAIN) { E.fused(acc, cur, wr, wc, fr, fq, lds, wid, lane); S.done(cur); }
#undef PG8_SA
#undef PG8_SB
#undef PG8_STAGE
#undef PG8_LDA
#undef PG8_STAGEA
#undef PG8_STAGEA_N
#undef PG8_WAIT_SEL
#undef PG8_KLOOP
#undef PG8_LDB
#undef PG8_MMA
#undef PG8_WAIT_V
#undef PG8_WAIT_L
#undef PG8_BAR
#undef PG8_SCHED
}
}

__device__ __forceinline__ unsigned f2bf(float f) { unsigned u = __builtin_bit_cast(unsigned, f); return (u + 0x7fffu + ((u >> 16) & 1u)) >> 16; }
__device__ __forceinline__ unsigned pk2(float lo, float hi) { return f2bf(lo) | (f2bf(hi) << 16); }
__device__ __forceinline__ float bf2f(bf16 b) { return __builtin_bit_cast(float, (unsigned)b << 16); }
__device__ __forceinline__ float wave_sum(float v) {
#pragma unroll
    for (int o = 1; o < 64; o <<= 1) v += __shfl_xor(v, o);
    return v;
}

__device__ __forceinline__ int t5_bucket_dev(int rel) {
    const int n = rel < 0 ? -rel : rel; const int sign = rel > 0 ? 16 : 0;
    const float nf = (float)(n > 1 ? n : 1);
    int large = 8 + (int)(logf(nf / 8.0f) / 4.852030263919617f * 8.0f);
    large = large < 15 ? large : 15;
    return sign + (n < 8 ? n : large);
}

struct MKArgs { const float* in[21]; float* out; unsigned char* ws; int ph_lo, ph_hi; };
typedef MKArgs ProArgs;
__device__ __forceinline__ void cvt_item(const float* W, int ldw, int c0, int nvalid, const float* gain, bf16* dst0, int K, int k0, LAS float* scr, int lane) {
    if (nvalid == 32) {
        const int kr = lane >> 3, c4 = (lane & 7) * 4;
        f32x4 v[8];
#pragma unroll
        for (int i = 0; i < 8; ++i) v[i] = *(const f32x4*)(W + (size_t)(k0 + 8 * i + kr) * ldw + c0 + c4);
#pragma unroll
        for (int i = 0; i < 8; ++i) { const int kk = 8 * i + kr; const float gsc = gain ? gain[k0 + kk] : 1.0f;
            scr[kk * 33 + c4] = v[i][0] * gsc; scr[kk * 33 + c4 + 1] = v[i][1] * gsc; scr[kk * 33 + c4 + 2] = v[i][2] * gsc; scr[kk * 33 + c4 + 3] = v[i][3] * gsc; }
    } else {
#pragma unroll 8
        for (int i = 0; i < 32; ++i) { const int kk = 2 * i + (lane >> 5), j = lane & 31;
            float v = (j < nvalid) ? W[(size_t)(k0 + kk) * ldw + c0 + j] : 0.f; if (gain) v *= gain[k0 + kk];
            scr[kk * 33 + j] = v; }
    }
    asm volatile("s_waitcnt lgkmcnt(0)" ::: "memory");
    const int c = lane & 7;
#pragma unroll
    for (int jj = 0; jj < 4; ++jj) { const int n = (lane >> 3) + 8 * jj; const LAS float* s = scr + (8 * c) * 33 + pg8::perm32(n);
        v4u o; o.x = pk2(s[0 * 33], s[1 * 33]); o.y = pk2(s[2 * 33], s[3 * 33]); o.z = pk2(s[4 * 33], s[5 * 33]); o.w = pk2(s[6 * 33], s[7 * 33]);
        *(v4u*)(dst0 + (size_t)n * K + k0 + 8 * c) = o; }
    asm volatile("s_waitcnt lgkmcnt(0)" ::: "memory");
}
constexpr int IT_GU = (NGU / 32) * (DM / 64), IT_D = (DM / 32) * (DFF / 64), IT_IN = (NINP / 32) * (DM / 64), IT_O = (DM / 32) * (DM / 64);
constexpr int IT_LAYER = 2 * IT_GU + 2 * IT_D + IT_IN + IT_O;
typedef const float* cfp;
#define CAS __attribute__((address_space(4)))
struct CvtD { const float* W; const float* gain; bf16* dst0; int ldw, c0, nvalid, K, k0; };
__device__ __forceinline__ CvtD cvt_decode(const CAS cfp* inp, unsigned char* ws, int it) {
    CvtD d;
    const int l = it / IT_LAYER; int r = it % IT_LAYER;
    unsigned char* wl = ws + WS_W + (size_t)l * W_LAYER;
    if (r < 2 * IT_GU) {
        const int f = r / IT_GU; r %= IT_GU;
        const float* Wg = inp[f ? 18 : 3] + (size_t)l * DM * DFF; const float* Wu = inp[f ? 19 : 4] + (size_t)l * DM * DFF;
        const int ng = NGU / 32, kb = r / ng, g = r % ng, pn = g >> 3, bj = (g >> 2) & 1, wc = g & 3;
        d.W = bj ? Wu : Wg; d.ldw = DFF; d.c0 = 128 * pn + 32 * wc; d.nvalid = 32; d.gain = inp[f ? 17 : 2] + (size_t)l * DM; d.dst0 = (bf16*)(wl + (f ? OFF_GU2 : OFF_GU1)) + (size_t)(32 * g) * DM; d.K = DM; d.k0 = 64 * kb;
        return d;
    }
    r -= 2 * IT_GU;
    if (r < 2 * IT_D) {
        const int f = r / IT_D; r %= IT_D;
        const int ng = DM / 32, kb = r / ng, g = r % ng;
        d.W = inp[f ? 20 : 5] + (size_t)l * DFF * DM; d.ldw = DM; d.c0 = 32 * g; d.nvalid = 32; d.gain = nullptr; d.dst0 = (bf16*)(wl + (f ? OFF_D2 : OFF_D1)) + (size_t)(32 * g) * DFF; d.K = DFF; d.k0 = 64 * kb;
        return d;
    }
    r -= 2 * IT_D;
    if (r < IT_IN) {
        const int ng = NINP / 32, kb = r / ng, g = r % ng, pn = g >> 3, bj = (g >> 2) & 1, wc = g & 3, v = 4 * pn + wc;
        const int c0 = (v < 44 ? 64 * v : (v == 44 ? 3200 : (v < 51 ? 2816 + 64 * (v - 45) : NIN))) + 32 * bj;
        int nv = (v == 44 ? 3224 : (v < 51 ? 1 << 30 : 0)) - c0; nv = nv < 0 ? 0 : (nv > 32 ? 32 : nv);
        d.W = inp[7] + (size_t)l * DM * NIN; d.ldw = NIN; d.c0 = nv > 0 ? c0 : 0; d.nvalid = nv; d.gain = inp[6] + (size_t)l * DM; d.dst0 = (bf16*)(wl + OFF_IN) + (size_t)(32 * g) * DM; d.K = DM; d.k0 = 64 * kb;
        return d;
    }
    r -= IT_IN;
    {   const int ng = DM / 32, kb = r / ng, g = r % ng;
        d.W = inp[16] + (size_t)l * DM * DM; d.ldw = DM; d.c0 = 32 * g; d.nvalid = 32; d.gain = nullptr; d.dst0 = (bf16*)(wl + OFF_O) + (size_t)(32 * g) * DM; d.K = DM; d.k0 = 64 * kb; }
    return d;
}
__device__ __forceinline__ void cvt_out(const CvtD& d, LAS float* scr, int lane) {
    const int c = lane & 7;
#pragma unroll
    for (int jj = 0; jj < 4; ++jj) { const int n = (lane >> 3) + 8 * jj; const LAS float* s = scr + (8 * c) * 33 + pg8::perm32(n);
        v4u o; o.x = pk2(s[0 * 33], s[1 * 33]); o.y = pk2(s[2 * 33], s[3 * 33]); o.z = pk2(s[4 * 33], s[5 * 33]); o.w = pk2(s[6 * 33], s[7 * 33]);
        *(v4u*)(d.dst0 + (size_t)n * d.K + d.k0 + 8 * c) = o; }
}
__device__ __forceinline__ void cvt_pair(const CvtD& a, const CvtD& b, LAS float* scr, int lane) {
    const int kr = lane >> 3, c4 = (lane & 7) * 4; LAS float* sb = scr + 64 * 33;
    f32x4 va[8], vb[8];
#pragma unroll
    for (int i = 0; i < 8; ++i) va[i] = *(const f32x4*)(a.W + (size_t)(a.k0 + 8 * i + kr) * a.ldw + a.c0 + c4);
#pragma unroll
    for (int i = 0; i < 8; ++i) vb[i] = *(const f32x4*)(b.W + (size_t)(b.k0 + 8 * i + kr) * b.ldw + b.c0 + c4);
#pragma unroll
    for (int i = 0; i < 8; ++i) { const int kk = 8 * i + kr; const float ga = a.gain ? a.gain[a.k0 + kk] : 1.0f, gb = b.gain ? b.gain[b.k0 + kk] : 1.0f;
        scr[kk * 33 + c4] = va[i][0] * ga; scr[kk * 33 + c4 + 1] = va[i][1] * ga; scr[kk * 33 + c4 + 2] = va[i][2] * ga; scr[kk * 33 + c4 + 3] = va[i][3] * ga;
        sb[kk * 33 + c4] = vb[i][0] * gb; sb[kk * 33 + c4 + 1] = vb[i][1] * gb; sb[kk * 33 + c4 + 2] = vb[i][2] * gb; sb[kk * 33 + c4 + 3] = vb[i][3] * gb; }
    asm volatile("s_waitcnt lgkmcnt(0)" ::: "memory");
    cvt_out(a, scr, lane); cvt_out(b, sb, lane);
    asm volatile("s_waitcnt lgkmcnt(0)" ::: "memory");
}
constexpr int CVT_WAVE_LDS = 2 * 64 * 33 * 4;
__device__ __forceinline__ void convert_weights(const CAS cfp* inp, unsigned char* ws, LAS unsigned char* lds, int gw, int NGW, int wave, int lane, int part) {
    LAS float* scr = (LAS float*)(lds + wave * CVT_WAVE_LDS);
    bool have = false; CvtD pend;
#pragma unroll 1
    for (int it = gw; it < DEPTH * IT_LAYER; it += NGW) {
        const int l = it / IT_LAYER, r = it % IT_LAYER;
        const bool early = (l == 0) && (r < IT_GU || (r >= 2 * IT_GU && r < 2 * IT_GU + IT_D) || (r >= 2 * IT_GU + 2 * IT_D && r < 2 * IT_GU + 2 * IT_D + IT_IN));
        if (early != (part == 0)) continue;
        const CvtD d = cvt_decode(inp, ws, it);
        if (d.nvalid != 32) { cvt_item(d.W, d.ldw, d.c0, d.nvalid, d.gain, d.dst0, d.K, d.k0, scr, lane); continue; }
        if (have) { cvt_pair(pend, d, scr, lane); have = false; } else { pend = d; have = true; }
    }
    if (have) cvt_item(pend.W, pend.ldw, pend.c0, pend.nvalid, pend.gain, pend.dst0, pend.K, pend.k0, scr, lane);
}
__device__ __forceinline__ void prologue_phase(const CAS cfp* inp, unsigned char* ws, LAS unsigned char* lds, int gw, int NGW, int wave, int lane) {
    convert_weights(inp, ws, lds, gw, NGW, wave, lane, 0);
    {
        float* pb = (float*)(ws + WS_PB);
        for (int i = gw * 64 + lane; i < PB_FLOATS; i += NGW * 64) {
            float v = 0.f;
            if (i >= PB_TB) { const int k = i - PB_TB, hb = k / 136, idx = k % 136, h = hb / 3, br = hb % 3, dil = br == 0 ? 1 : (br == 1 ? 4 : 16);
                v = idx <= 128 ? inp[1][t5_bucket_dev((idx - 64) * dil) * 6 + h] * 1.4426950408889634f : 0.f; }
            else if (i >= PB_REL) v = inp[1][i - PB_REL];
            else { const int l = i / PB_LAYER, r = i % PB_LAYER;
                if (r < 64) v = inp[8][l * 64 + r]; else if (r < 128) v = inp[9][l * 64 + r - 64]; else if (r < 192) v = inp[10][l * 64 + r - 128]; else if (r < 256) v = inp[11][l * 64 + r - 192];
                else if (r < 320) v = inp[15][l * 64 + r - 256]; else if (r < 332) v = inp[13][l * 12 + r - 320]; else if (r < 344) v = inp[14][l * 12 + r - 332];
                else if (r == PB_REFA || r == PB_REFB) {
                    const float* gq = inp[r == PB_REFA ? 8 : 10] + l * 64; const float* gk = inp[r == PB_REFA ? 9 : 11] + l * 64; float mq = 0.f, mk = 0.f, mb = 0.f;
                    for (int e = 0; e < 64; ++e) { mq = fmaxf(mq, fabsf(gq[e])); mk = fmaxf(mk, fabsf(gk[e])); }
                    if (r == PB_REFB) for (int e = 0; e < 192; ++e) mb = fmaxf(mb, inp[1][e] * 1.4426950408889634f);
                    v = 0.125f * 1.4426950408889634f * 64.0f * mq * mk + mb; }
                else if (r >= PB_CONV) v = inp[12][(size_t)l * 5760 + r - PB_CONV]; }
            pb[i] = v; }
    }
    const float* x = inp[0]; bf16* hb = (bf16*)(ws + WS_HB); float* ssq = (float*)(ws + WS_SSQ);
#pragma unroll 1
    for (int m0 = gw; m0 < MT; m0 += 4 * NGW) {
        f32x4 v[4][4];
#pragma unroll
        for (int r = 0; r < 4; ++r) { const int m = m0 + r * NGW; const f32x4* xr = (const f32x4*)(x + (size_t)(m < MT ? m : gw) * DM) + lane;
#pragma unroll
            for (int j = 0; j < 4; ++j) v[r][j] = xr[64 * j]; }
#pragma unroll
        for (int r = 0; r < 4; ++r) { const int m = m0 + r * NGW; if (m >= MT) break;
            unsigned long long* o8 = (unsigned long long*)(hb + (size_t)m * DM) + lane;
#pragma unroll
            for (int j = 0; j < 4; ++j) { const f32x4 w = v[r][j];
                o8[64 * j] = (unsigned long long)pk2(w[0], w[1]) | ((unsigned long long)pk2(w[2], w[3]) << 32);
                float s = (w[0] * w[0] + w[1] * w[1]) + (w[2] * w[2] + w[3] * w[3]);
                s += __shfl_xor(s, 1); s += __shfl_xor(s, 2); s += __shfl_xor(s, 4); s += __shfl_xor(s, 8);
                if ((lane & 15) == 0) ssq[(size_t)m * 16 + 4 * j + (lane >> 4)] = s; }
        }
    }
}
namespace att {
typedef short bf16x8 __attribute__((ext_vector_type(8)));
typedef short v4i16 __attribute__((ext_vector_type(4)));
typedef float f32x16 __attribute__((ext_vector_type(16)));
typedef float f32x2_t __attribute__((ext_vector_type(2)));
typedef __bf16 bf16x2_t __attribute__((ext_vector_type(2)));
constexpr int NS = 4, DP = 3;
constexpr int L_K = 0, L_V = NS * 8192, L_WS = 2 * NS * 8192, L_TB = L_WS + 2048, L_OST = L_TB + 18 * 544, L_END = L_OST + 8 * 4096;
__device__ __forceinline__ void ring_wait(int rem) {
    if (rem >= 2) asm volatile("s_waitcnt vmcnt(4)" ::: "memory"); else if (rem == 1) asm volatile("s_waitcnt vmcnt(2)" ::: "memory"); else asm volatile("s_waitcnt vmcnt(0)" ::: "memory");
    __builtin_amdgcn_s_barrier(); asm volatile("" ::: "memory");
}
__device__ __forceinline__ int crow(int r, int hi) { return (r & 3) + 8 * (r >> 2) + 4 * hi; }
__device__ __forceinline__ unsigned cvtpk(float lo, float hi) { f32x2_t v = {lo, hi}; bf16x2_t b = __builtin_convertvector(v, bf16x2_t); return __builtin_bit_cast(unsigned, b); }
__device__ __forceinline__ v4i16 vtr(const LAS char* p) { return __builtin_amdgcn_ds_read_tr16_b64_v4i16((LAS v4i16*)p); }
__device__ __forceinline__ void stage16(const void* gsrc, LAS unsigned char* dst_wave_uniform) { unsigned keep; const unsigned d = (unsigned)__builtin_amdgcn_readfirstlane((int)(unsigned)(uintptr_t)dst_wave_uniform);
    asm volatile("s_mov_b32 %0, m0\n\ts_mov_b32 m0, %2\n\ts_nop 0\n\tglobal_load_lds_dwordx4 %1, off\n\ts_mov_b32 m0, %0" : "=&s"(keep) : "v"(gsrc), "s"(d) : "memory"); }

template <int MODE>
__device__ __forceinline__ void tile_compute(const LAS char* Kb, const LAS char* Vb, const bf16x8 (&qf)[4], f32x16 (&o)[2], float& lsum, float negref, int r32, int hi, int lane,
                                             int ik0, int iq, int L, const LAS float* tb) {
    f32x16 p0, p1;
#pragma unroll
    for (int r = 0; r < 16; ++r) { p0[r] = negref; p1[r] = negref; }
    const LAS char* kp = Kb + hi * 1024 + r32 * 16;
    bf16x8 kf0[4], kf1[4];
#pragma unroll
    for (int s = 0; s < 4; ++s) { kf0[s] = *(const LAS bf16x8*)(kp + s * 2048); kf1[s] = *(const LAS bf16x8*)(kp + s * 2048 + 512); }
    __builtin_amdgcn_s_setprio(1);
#pragma unroll
    for (int s = 0; s < 4; ++s) {
        p0 = __builtin_amdgcn_mfma_f32_32x32x16_bf16(kf0[s], qf[s], p0, 0, 0, 0);
        p1 = __builtin_amdgcn_mfma_f32_32x32x16_bf16(kf1[s], qf[s], p1, 0, 0, 0);
    }
    __builtin_amdgcn_s_setprio(0);
    if (MODE == 1) {
        const int d0 = ik0 - iq + 64;
        {   float bb[16];
#pragma unroll
            for (int r = 0; r < 16; ++r) bb[r] = tb[min(max(d0 + crow(r, hi), 0), 128)];
#pragma unroll
            for (int r = 0; r < 16; ++r) { const int x0 = d0 + crow(r, hi); p0[r] = __builtin_amdgcn_exp2f(p0[r] + (((unsigned)x0 <= 128u) ? bb[r] : -1e30f)); }
        }
        {   float bb[16];
#pragma unroll
            for (int r = 0; r < 16; ++r) bb[r] = tb[min(max(d0 + 32 + crow(r, hi), 0), 128)];
#pragma unroll
            for (int r = 0; r < 16; ++r) { const int x1 = d0 + 32 + crow(r, hi); p1[r] = __builtin_amdgcn_exp2f(p1[r] + (((unsigned)x1 <= 128u) ? bb[r] : -1e30f)); }
        }
    } else {
#pragma unroll
        for (int r = 0; r < 16; ++r) { p0[r] = __builtin_amdgcn_exp2f(p0[r]); p1[r] = __builtin_amdgcn_exp2f(p1[r]); }
    }
    float sa = 0.f, sb = 0.f;
#pragma unroll
    for (int r = 0; r < 16; ++r) { sa += p0[r]; sb += p1[r]; }
    lsum += sa + sb;
    bf16x8 pa[4];
#pragma unroll
    for (int ks = 0; ks < 4; ++ks) {
        unsigned w[4];
#pragma unroll
        for (int e = 0; e < 4; ++e) { const int r = 8 * (ks & 1) + 2 * e; w[e] = (ks < 2) ? cvtpk(p0[r], p0[r + 1]) : cvtpk(p1[r], p1[r + 1]); }
        typedef unsigned u32x4_t __attribute__((ext_vector_type(4)));
        const u32x4_t wv = {w[0], w[1], w[2], w[3]};
        pa[ks] = __builtin_bit_cast(bf16x8, wv);
    }
    const LAS char* vp = Vb + ((lane >> 4) & 1) * 32 + (lane & 3) * 8 + (4 * hi + ((lane & 15) >> 2)) * 64;
#pragma unroll
    for (int dh = 0; dh < 2; ++dh) {
        bf16x8 vf[4];
#pragma unroll
        for (int ks = 0; ks < 4; ++ks) { const v4i16 lo = vtr(vp + dh * 4096 + ks * 1024), hh = vtr(vp + dh * 4096 + ks * 1024 + 512); vf[ks] = (bf16x8){lo[0], lo[1], lo[2], lo[3], hh[0], hh[1], hh[2], hh[3]}; }
        __builtin_amdgcn_s_setprio(1);
#pragma unroll
        for (int ks = 0; ks < 4; ++ks) o[dh] = __builtin_amdgcn_mfma_f32_32x32x16_bf16(pa[ks], vf[ks], o[dh], 0, 0, 0);
        __builtin_amdgcn_s_setprio(0);
    }
}

template <class RowPtr> __device__ __forceinline__ void store_tile(LAS unsigned char* stg, const f32x16 (&o)[2], const float (&sc)[16], int r32, int hi, int lane, RowPtr rowptr) {
#pragma unroll
    for (int r = 0; r < 16; ++r) { const int q = crow(r, hi);
        *(LAS unsigned short*)(stg + q * 128 + r32 * 2) = (unsigned short)cvtpk(o[0][r] * sc[r], 0.f); *(LAS unsigned short*)(stg + q * 128 + 64 + r32 * 2) = (unsigned short)cvtpk(o[1][r] * sc[r], 0.f); }
    asm volatile("s_waitcnt lgkmcnt(0)" ::: "memory");
    typedef unsigned u32x4_t __attribute__((ext_vector_type(4)));
#pragma unroll
    for (int i = 0; i < 4; ++i) { const int row = i * 8 + (lane >> 3), ch = lane & 7; const u32x4_t v = *(const LAS u32x4_t*)(stg + row * 128 + ch * 16); *(u32x4_t*)(rowptr(row) + ch * 8) = v; }
}

__device__ __forceinline__ void itemA(LAS unsigned char* lds, int item, int tid, unsigned char* ws, float refA, bf16* Obase, int opitch) {
    const int lane = tid & 63, wave = __builtin_amdgcn_readfirstlane(tid >> 6), r32 = lane & 31, hi = lane >> 5;
    const int qb = item & 7, h = (item >> 3) & 3, b = item >> 5, kvh = h >> 1;
    bf16* QO = (bf16*)(ws + WS_QO); const bf16* KA = (const bf16*)(ws + WS_KA); const bf16* VA = (const bf16*)(ws + WS_VA);
    const size_t rowbase = (size_t)b * SEQ;
    const bf16* ksrc = KA + (rowbase + lane) * 128 + kvh * 64 + wave * 8;
    const bf16* vsrc = VA + (rowbase + 16 * (wave & 3) + (lane >> 2)) * 128 + kvh * 64 + (wave >> 2) * 32 + (lane & 3) * 8;
    LAS unsigned char* kdst = lds + L_K + wave * 1024; LAS unsigned char* vdst = lds + L_V + wave * 1024;
#pragma unroll
    for (int t = 0; t < DP; ++t) { stage16(ksrc + (size_t)t * 64 * 128, kdst + t * 8192); stage16(vsrc + (size_t)t * 64 * 128, vdst + t * 8192); }
    bf16* qrow = QO + (rowbase + qb * 256 + wave * 32 + r32) * 1024 + h * 64;
    bf16x8 qf[4];
#pragma unroll
    for (int s = 0; s < 4; ++s) qf[s] = *(const bf16x8*)(qrow + 16 * s + 8 * hi);
    asm volatile("" : "+v"(qf[0]), "+v"(qf[1]), "+v"(qf[2]), "+v"(qf[3]));
    f32x16 o[2];
#pragma unroll
    for (int r = 0; r < 16; ++r) { o[0][r] = 0.f; o[1][r] = 0.f; }
    float lsum = 0.f; const float negref = -refA;
    constexpr int NT = SEQ / 64;
#pragma unroll 1
    for (int t = 0; t < NT; ++t) {
        ring_wait(NT - 1 - t);
        const int cur = t & (NS - 1), nxt = (t + DP) & (NS - 1);
        if (t + DP < NT) { stage16(ksrc + (size_t)(t + DP) * 64 * 128, kdst + nxt * 8192); stage16(vsrc + (size_t)(t + DP) * 64 * 128, vdst + nxt * 8192); }
        tile_compute<0>((const LAS char*)(lds + L_K + cur * 8192), (const LAS char*)(lds + L_V + cur * 8192), qf, o, lsum, negref, r32, hi, lane, 0, 0, 0, nullptr);
    }
    lsum += __shfl_xor(lsum, 32);
    LAS float* wsf = (LAS float*)(lds + L_WS) + wave * 64;
    if (hi == 0) wsf[r32] = lsum;
    asm volatile("s_waitcnt lgkmcnt(0)" ::: "memory");
    float rl[16];
#pragma unroll
    for (int r = 0; r < 16; ++r) rl[r] = __builtin_amdgcn_rcpf(wsf[crow(r, hi)]);
    { bf16* ob = Obase + (rowbase + qb * 256 + wave * 32) * opitch + h * 64; const int op_ = opitch;
      store_tile(lds + L_OST + wave * 4096, o, rl, r32, hi, lane, [=](int row) { return ob + (size_t)row * op_; }); }
    __syncthreads();
}

__device__ __forceinline__ void fill_tables(LAS unsigned char* lds, const float* tbg, int tid) {
    for (int i = tid; i < 18 * 136; i += 512) ((LAS float*)(lds + L_TB))[i] = tbg[i];
    __syncthreads();
}
__device__ __forceinline__ void itemB(LAS unsigned char* lds, int item, int tid, unsigned char* ws, float refB, bf16* const (&Pb)[3], float* const (&Lb)[3]) {
    const int lane = tid & 63, wave = __builtin_amdgcn_readfirstlane(tid >> 6), r32 = lane & 31, hi = lane >> 5;
    const int br = item < 192 ? 0 : (item < 384 ? 1 : 2), rem = br == 2 ? item - 384 : (br == 1 ? item - 192 : item);
    const int bh = br == 2 ? rem >> 3 : rem >> 2, sub = br == 2 ? rem & 7 : rem & 3, b = bh / 6, h = bh % 6;
    const int dil = br == 0 ? 1 : (br == 1 ? 4 : 16), L = SEQ / dil;
    const int ntiles = br == 2 ? 4 : 10, nblk = br == 2 ? 1 : 2;
    const int I0 = br == 0 ? 512 * sub : 0;
    const int resw = br == 0 ? 0 : (br == 1 ? sub : (2 * sub + (wave >> 2)));
    const int iq0 = br == 2 ? 32 * (wave & 3) : I0 + 32 * wave, jlo = br == 2 ? 2 * (wave >> 2) : (wave >> 1), jcnt = br == 2 ? 2 : 3;
    const bf16* QO = (const bf16*)(ws + WS_QO); const bf16* KB = (const bf16*)(ws + WS_KB); const bf16* VB = (const bf16*)(ws + WS_VB);
    bf16* Pout = Pb[0]; float* Lout = Lb[0]; if (br == 1) { Pout = Pb[1]; Lout = Lb[1]; } else if (br == 2) { Pout = Pb[2]; Lout = Lb[2]; }
    const size_t rowbase = (size_t)b * SEQ;
    const LAS float* tb = (const LAS float*)(lds + L_TB) + (h * 3 + br) * 136;
    LAS unsigned char* kdst = lds + L_K + wave * 1024; LAS unsigned char* vdst = lds + L_V + wave * 1024;
#define STAGE_TILE(j, buf) do { \
        const int res_ = br == 0 ? 0 : (br == 1 ? sub : (2 * sub + ((j) >> 1))); \
        const int ikb_ = br == 2 ? 64 * ((j) & 1) : I0 - 64 + 64 * (j); \
        int ik_ = ikb_ + lane; ik_ = ik_ < 0 ? 0 : (ik_ > L - 1 ? L - 1 : ik_); \
        stage16(KB + (rowbase + res_ + dil * ik_) * 384 + h * 64 + wave * 8, kdst + (buf) * 8192); \
        int iv_ = ikb_ + 16 * (wave & 3) + (lane >> 2); iv_ = iv_ < 0 ? 0 : (iv_ > L - 1 ? L - 1 : iv_); \
        stage16(VB + (rowbase + res_ + dil * iv_) * 384 + h * 64 + (wave >> 2) * 32 + (lane & 3) * 8, vdst + (buf) * 8192); } while (0)
    for (int j = 0; j < DP; ++j) STAGE_TILE(j, j);
    const bf16* qbase = QO + (rowbase + resw + (size_t)dil * (iq0 + r32)) * 1024 + 256 + h * 64 + 8 * hi;
    bf16x8 qf[4], qn[4];
#pragma unroll
    for (int s = 0; s < 4; ++s) { qf[s] = *(const bf16x8*)(qbase + 16 * s); qn[s] = nblk == 2 ? *(const bf16x8*)(qbase + (size_t)dil * 256 * 1024 + 16 * s) : qf[s]; }
    asm volatile("" : "+v"(qf[0]), "+v"(qf[1]), "+v"(qf[2]), "+v"(qf[3]), "+v"(qn[0]), "+v"(qn[1]), "+v"(qn[2]), "+v"(qn[3]));
    f32x16 o[2];
#pragma unroll
    for (int r = 0; r < 16; ++r) { o[0][r] = 0.f; o[1][r] = 0.f; }
    float lsum = 0.f; const float negref = -refB;
    int iqc = iq0, jl = jlo;
    auto flush = [&](int iqb) {
        float ls = lsum + __shfl_xor(lsum, 32);
        if (hi == 0) Lout[(rowbase + resw + (size_t)dil * (iqb + r32)) * 6 + h] = ls;
        float one[16];
#pragma unroll
        for (int r = 0; r < 16; ++r) one[r] = 1.0f;
        bf16* ob = Pout + h * 64; const size_t rb_ = rowbase + resw; const int dil_ = dil;
        store_tile(lds + L_OST + wave * 4096, o, one, r32, hi, lane, [=](int row) { return ob + (rb_ + (size_t)dil_ * (iqb + row)) * 384; });
    };
#pragma unroll 1
    for (int j = 0; j < ntiles; ++j) {
        ring_wait(ntiles - 1 - j);
        const int cur = j & (NS - 1);
        if (j + DP < ntiles) STAGE_TILE(j + DP, (j + DP) & (NS - 1));
        if (nblk == 2 && j == jlo + 3) {
            flush(iq0);
#pragma unroll
            for (int r = 0; r < 16; ++r) { o[0][r] = 0.f; o[1][r] = 0.f; }
            lsum = 0.f; iqc = iq0 + 256; jl = jlo + 4;
#pragma unroll
            for (int s = 0; s < 4; ++s) qf[s] = qn[s];
        }
        const int ikb = br == 2 ? 64 * (j & 1) : I0 - 64 + 64 * j;
        if (j >= jl && j < jl + jcnt && ikb >= 0 && ikb < L) {
            tile_compute<1>((const LAS char*)(lds + L_K + cur * 8192), (const LAS char*)(lds + L_V + cur * 8192), qf, o, lsum, negref, r32, hi, lane, ikb, iqc + r32, L, tb);
        }
    }
    flush(iqc);
    __syncthreads();
#undef STAGE_TILE
}
__device__ __forceinline__ void finalizeB(int gtid, int nthreads, unsigned char* ws, const bf16* P0, const bf16* P1, const bf16* P2, const float* L0, const float* L1, const float* L2) {
    bf16* QO = (bf16*)(ws + WS_QO);
    for (int i = gtid; i < MT * 48; i += nthreads) {
        const int row = i / 48, c8 = i % 48, h = c8 >> 3;
        const float l = L0[(size_t)row * 6 + h] + L1[(size_t)row * 6 + h] + L2[(size_t)row * 6 + h]; const float rl = 1.0f / l;
        const v4u a = *(const v4u*)(P0 + (size_t)row * 384 + c8 * 8), bq = *(const v4u*)(P1 + (size_t)row * 384 + c8 * 8), c = *(const v4u*)(P2 + (size_t)row * 384 + c8 * 8);
        v4u o;
#pragma unroll
        for (int e = 0; e < 4; ++e) {
            const float lo = (bf2f((bf16)(a[e] & 0xffff)) + bf2f((bf16)(bq[e] & 0xffff)) + bf2f((bf16)(c[e] & 0xffff))) * rl;
            const float hi2 = (bf2f((bf16)(a[e] >> 16)) + bf2f((bf16)(bq[e] >> 16)) + bf2f((bf16)(c[e] >> 16))) * rl;
            o[e] = pk2(lo, hi2);
        }
        *(v4u*)(QO + (size_t)row * 1024 + 256 + c8 * 8) = o;
    }
}
}
#ifndef PROBE_STAGE
#define PROBE_STAGE 0
#endif
namespace cdn {
typedef short bf16x8 __attribute__((ext_vector_type(8)));
typedef short bf16x4 __attribute__((ext_vector_type(4)));
typedef short v4i16 __attribute__((ext_vector_type(4)));
typedef float f32x16 __attribute__((ext_vector_type(16)));
typedef float f32x4v __attribute__((ext_vector_type(4)));
typedef unsigned u32x4 __attribute__((ext_vector_type(4)));
constexpr int P = 144;
constexpr int QS = 0, KS = 9216, VS = 18432, AS = 27648, MS = 36864, TS = 46080, TES = 55296, WSS = 64512, MF = 73728, UF = MF + 8192, UP = 272, GC = UF + 64 * UP, BETA = GC + 256, EG = BETA + 256, EGL = EG + 256, LEND = EGL + 256;
static_assert(LEND <= 131072, "LDS");
__device__ __forceinline__ int crow(int r, int hi) { return (r & 3) + 8 * (r >> 2) + 4 * hi; }
__device__ __forceinline__ unsigned cvtpk(float lo, float hi) { typedef float f2 __attribute__((ext_vector_type(2))); typedef __bf16 b2 __attribute__((ext_vector_type(2))); f2 v = {lo, hi}; b2 b = __builtin_convertvector(v, b2); return __builtin_bit_cast(unsigned, b); }
__device__ __forceinline__ bf16x8 pack8(float a0, float a1, float a2, float a3, float a4, float a5, float a6, float a7) { const u32x4 w = {cvtpk(a0, a1), cvtpk(a2, a3), cvtpk(a4, a5), cvtpk(a6, a7)}; return __builtin_bit_cast(bf16x8, w); }
__device__ __forceinline__ v4i16 vtr(const LAS unsigned char* p) { return __builtin_amdgcn_ds_read_tr16_b64_v4i16((LAS v4i16*)p); }
__device__ __forceinline__ bf16x8 cat4(v4i16 a, v4i16 b) { return (bf16x8){a[0], a[1], a[2], a[3], b[0], b[1], b[2], b[3]}; }
__device__ __forceinline__ bf16x8 ld8(const LAS unsigned char* p) { return *(const LAS bf16x8*)p; }
__device__ __forceinline__ bf16x8 ld44(const LAS unsigned char* p0, const LAS unsigned char* p1) { const v4i16 a = *(const LAS v4i16*)p0, b = *(const LAS v4i16*)p1; return cat4(a, b); }
__device__ __forceinline__ void st_bf(LAS unsigned char* p, float v) { *(LAS unsigned short*)p = (unsigned short)cvtpk(v, v); }
__device__ __forceinline__ void st_bf2(LAS unsigned char* p0, LAS unsigned char* p1, float v0, float v1) { const unsigned w = cvtpk(v0, v1); *(LAS unsigned short*)p0 = (unsigned short)w; *(LAS unsigned short*)p1 = (unsigned short)(w >> 16); }
#define MFMA32(a, b, c) __builtin_amdgcn_mfma_f32_32x32x16_bf16((a), (b), (c), 0, 0, 0)
#define MFMA16(a, b, c) __builtin_amdgcn_mfma_f32_16x16x32_bf16((a), (b), (c), 0, 0, 0)

__device__ __forceinline__ void prep_item(int item, int lane, unsigned char* ws, unsigned char* xs, const float* convw) {
    const int blk = item / 18, hs = item % 18, seg = lane >> 3, g8 = lane & 7;
    const int ch = hs * 64 + g8 * 8;
    const int t0 = (blk & 31) * 64 + seg * 8; const size_t rowb = (size_t)(blk >> 5) * SEQ;
    const bf16* CR = (const bf16*)(ws + WS_CR);
    u32x4 raw[12];
#pragma unroll
    for (int k = 0; k < 12; ++k) { const int t = t0 + k - 2; raw[k] = (t >= 0 && t < SEQ) ? *(const u32x4*)(CR + (rowb + t) * 1152 + ch) : (u32x4){0u, 0u, 0u, 0u}; }
    float w[5][8];
#pragma unroll
    for (int tp = 0; tp < 5; ++tp) { const f32x4v a = *(const f32x4v*)(convw + tp * 1152 + ch), b = *(const f32x4v*)(convw + tp * 1152 + ch + 4);
        w[tp][0] = a[0]; w[tp][1] = a[1]; w[tp][2] = a[2]; w[tp][3] = a[3]; w[tp][4] = b[0]; w[tp][5] = b[1]; w[tp][6] = b[2]; w[tp][7] = b[3]; }
    bf16* dst = (bf16*)(hs < 6 ? xs + XS_QN : (hs < 12 ? xs + XS_KN : ws + WS_VC)) + (hs % 6) * 64 + g8 * 8;
#pragma unroll
    for (int k = 0; k < 8; ++k) {
        float acc[8];
#pragma unroll
        for (int e = 0; e < 8; ++e) acc[e] = 0.f;
#pragma unroll
        for (int tp = 0; tp < 5; ++tp) { const u32x4 r = raw[k + tp];
#pragma unroll
            for (int e = 0; e < 4; ++e) { acc[2 * e] += __builtin_bit_cast(float, r[e] << 16) * w[tp][2 * e]; acc[2 * e + 1] += __builtin_bit_cast(float, r[e] & 0xffff0000u) * w[tp][2 * e + 1]; } }
        float ss = 0.f;
#pragma unroll
        for (int e = 0; e < 8; ++e) { acc[e] = acc[e] * __builtin_amdgcn_rcpf(1.0f + __expf(-acc[e])); ss += acc[e] * acc[e]; }
        float sc = 1.f;
        if (hs < 12) { ss += __shfl_xor(ss, 1); ss += __shfl_xor(ss, 2); ss += __shfl_xor(ss, 4); sc = __builtin_amdgcn_rsqf(ss + 1e-6f) * (hs < 6 ? 0.125f : 1.0f); }
        const u32x4 o = {cvtpk(acc[0] * sc, acc[1] * sc), cvtpk(acc[2] * sc, acc[3] * sc), cvtpk(acc[4] * sc, acc[5] * sc), cvtpk(acc[6] * sc, acc[7] * sc)};
        *(u32x4*)(dst + (rowb + t0 + k) * 384) = o;
    }
}

__device__ __forceinline__ void kk_tile(LAS unsigned char* lds, int p, int MF1, int tl, int lane);
constexpr int QS2 = 0, KS2 = 18432, AS2 = 36864, WS2 = 55296, US2 = 73728, UPB = 136, VS2 = US2 + 2 * 64 * UPB, MS1 = VS2 + 18432, TS1 = MS1 + 9216, TES1 = TS1 + 9216,
              GC2 = TES1 + 9216, BETA2 = GC2 + 512, EG2 = BETA2 + 512, EGL2 = EG2 + 512, LEND2 = EGL2 + 512;
static_assert(LEND2 <= 139264, "LDS (scan)");
__device__ __forceinline__ void kk_tile(LAS unsigned char* lds, int p, int MF1, int tl, int lane) {
    const int ti = tl >= 6 ? 3 : (tl >= 3 ? 2 : (tl >= 1 ? 1 : 0)), tj = tl - ti * (ti + 1) / 2, l15 = lane & 15, g = lane >> 4;
    const LAS unsigned char* ap = lds + KS2 + p * 9216 + (16 * ti + l15) * P + 16 * g; const LAS unsigned char* bp = lds + KS2 + p * 9216 + (16 * tj + l15) * P + 16 * g;
    f32x4v acc = (f32x4v){0.f, 0.f, 0.f, 0.f};
    acc = MFMA16(ld8(ap), ld8(bp), acc); acc = MFMA16(ld8(ap + 64), ld8(bp + 64), acc);
    const int j = 16 * tj + l15, i0 = 16 * ti + 4 * g;
    const float gcj = *(const LAS float*)(lds + GC2 + p * 256 + 4 * j), bj = *(const LAS float*)(lds + BETA2 + p * 256 + 4 * j);
    const f32x4v gci = *(const LAS f32x4v*)(lds + GC2 + p * 256 + 4 * i0);
#pragma unroll
    for (int e = 0; e < 4; ++e) { const int i = i0 + e;
        const float v = (i > j) ? acc[e] * __builtin_amdgcn_exp2f(gci[e] - gcj) * bj : 0.f;
        st_bf(lds + MS1 + i * P + 2 * j, v);
        if ((ti >> 1) == (tj >> 1)) *(LAS float*)(lds + MF1 + ((ti >> 1) * 1024 + (i & 31) * 32 + (j & 31)) * 4) = v; }
}
__device__ constexpr int sub_qoff(int r) { int s = 0; for (int q = 1; q < r; ++q) s += (q + 3) / 4; return s; }
__device__ __forceinline__ void scan_item(LAS unsigned char* lds, int item, int tid, unsigned char* ws, unsigned char* xs) {
    const int lane0 = tid & 63, wave = __builtin_amdgcn_readfirstlane(tid >> 6);
    int lane = lane0, r32 = lane & 31, hi = lane >> 5, g = lane >> 4, l15 = lane & 15;
#define CDN_IDS() do { lane = lane0; asm volatile("" : "+v"(lane)); r32 = lane & 31; hi = lane >> 5; g = lane >> 4; l15 = lane & 15; } while (0)
    const int dir = item & 1, bh = item >> 1, b = bh / 6, h = bh % 6;
    const size_t rowbase = (size_t)b * SEQ;
    const bf16* QN = (const bf16*)(xs + XS_QN) + h * 64; const bf16* KN = (const bf16*)(xs + XS_KN) + h * 64; const bf16* VC = (const bf16*)(ws + WS_VC) + h * 64;
    const float* GT = (const float*)(ws + WS_GT);
    bf16* OUT = dir ? ((bf16*)(ws + WS_QO) + 640 + h * 64) : ((bf16*)(ws + WS_CF) + h * 64); const int opitch = dir ? 1024 : 384;
    for (int i = tid; i < 36864 / 16; i += 512) *(LAS u32x4*)(lds + AS2 + i * 16) = (u32x4){0u, 0u, 0u, 0u};
    for (int i = tid; i < 27648 / 16; i += 512) *(LAS u32x4*)(lds + MS1 + i * 16) = (u32x4){0u, 0u, 0u, 0u};
    f32x4v St[4];
#pragma unroll
    for (int t = 0; t < 4; ++t) St[t] = (f32x4v){0.f, 0.f, 0.f, 0.f};
    const int prow = (tid >> 3) & 31, pc16 = tid & 7;
    u32x4 nq0 = {0u, 0u, 0u, 0u}, nq1 = nq0, nk0 = nq0, nk1 = nq0, nv0 = nq0, nv1 = nq0; float ng = 0.f, nb = 0.f;
#define CDN_PREFETCH(n) do { if (wave < 4) { const int c_ = dir ? 31 - (n) : (n); const size_t t0_ = rowbase + 64 * c_ + (dir ? 63 - prow : prow), t1_ = rowbase + 64 * c_ + (dir ? 31 - prow : 32 + prow); \
        nq0 = *(const u32x4*)(QN + t0_ * 384 + pc16 * 8); nk0 = *(const u32x4*)(KN + t0_ * 384 + pc16 * 8); nv0 = *(const u32x4*)(VC + t0_ * 384 + pc16 * 8); \
        nq1 = *(const u32x4*)(QN + t1_ * 384 + pc16 * 8); nk1 = *(const u32x4*)(KN + t1_ * 384 + pc16 * 8); nv1 = *(const u32x4*)(VC + t1_ * 384 + pc16 * 8); \
        if (wave == 3) { const size_t tg_ = rowbase + 64 * c_ + (dir ? 63 - lane0 : lane0); ng = GT[tg_ * 32 + 12 + dir * 6 + h]; nb = GT[tg_ * 32 + dir * 6 + h]; } } } while (0)
#define CDN_STAGE(pp) do { if (wave < 4) { \
        *(LAS u32x4*)(lds + QS2 + (pp) * 9216 + prow * P + pc16 * 16) = nq0; *(LAS u32x4*)(lds + QS2 + (pp) * 9216 + (32 + prow) * P + pc16 * 16) = nq1; \
        *(LAS u32x4*)(lds + KS2 + (pp) * 9216 + prow * P + pc16 * 16) = nk0; *(LAS u32x4*)(lds + KS2 + (pp) * 9216 + (32 + prow) * P + pc16 * 16) = nk1; \
        *(LAS u32x4*)(lds + VS2 + (pp) * 9216 + prow * P + pc16 * 16) = nv0; *(LAS u32x4*)(lds + VS2 + (pp) * 9216 + (32 + prow) * P + pc16 * 16) = nv1; \
        if (wave == 3) { float x = ng; \
            _Pragma("unroll") for (int off = 1; off < 64; off <<= 1) { const float y = __shfl_up(x, off); if (lane0 >= off) x += y; } \
            const float tot = __shfl(x, 63); const float x2 = x * 1.4426950408889634f, t2 = tot * 1.4426950408889634f; \
            *(LAS float*)(lds + GC2 + (pp) * 256 + 4 * lane0) = x2; *(LAS float*)(lds + BETA2 + (pp) * 256 + 4 * lane0) = nb; \
            *(LAS float*)(lds + EG2 + (pp) * 256 + 4 * lane0) = __builtin_amdgcn_exp2f(x2); *(LAS float*)(lds + EGL2 + (pp) * 256 + 4 * lane0) = __builtin_amdgcn_exp2f(t2 - x2); } } } while (0)
    CDN_PREFETCH(0);
    CDN_STAGE(0);
    CDN_PREFETCH(1);
    __syncthreads();
#pragma unroll 1
    for (int it = 0; it <= 32; ++it) {
        const int p = it & 1, q = p ^ 1;
        const int MF1 = US2 + p * 64 * UPB;
        CDN_IDS();
        bf16x8 vs0 = {0, 0, 0, 0, 0, 0, 0, 0}, vs1 = vs0, vb0 = vs0, vb1 = vs0, Sb0 = vs0, Sb1 = vs0;
        if (wave >= 4) {
            if (it < 32) { kk_tile(lds, p, MF1, wave - 4, lane); kk_tile(lds, p, MF1, wave, lane); }
        } else {
#pragma unroll 1
            for (int rp_ = 0; rp_ < (PROBE_STAGE == 6 ? 2 : 1); ++rp_)
            if (it >= 1) {
                const int e = 16 * wave + l15, n = it - 1;
                const LAS unsigned char* Qb = lds + QS2 + q * 9216; const LAS unsigned char* Kb = lds + KS2 + q * 9216; const LAS unsigned char* Ab = lds + AS2 + q * 9216;
                const LAS unsigned char* Wb = lds + WS2 + q * 9216; const LAS unsigned char* Ub = lds + US2 + q * 64 * UPB; const LAS unsigned char* EGb = lds + EG2 + q * 256; const LAS unsigned char* ELb = lds + EGL2 + q * 256;
                Sb0 = pack8(St[0][0], St[0][1], St[0][2], St[0][3], St[1][0], St[1][1], St[1][2], St[1][3]);
                Sb1 = pack8(St[2][0], St[2][1], St[2][2], St[2][3], St[3][0], St[3][1], St[3][2], St[3][3]);
                f32x4v vn[4];
#pragma unroll
                for (int t4 = 0; t4 < 4; ++t4) {
                    const LAS unsigned char* wp = Wb + (4 * g + (l15 >> 2)) * P + (16 * t4 + 4 * (l15 & 3)) * 2;
                    f32x4v acc = (f32x4v){0.f, 0.f, 0.f, 0.f};
                    acc = MFMA16(cat4(vtr(wp), vtr(wp + 16 * P)), Sb0, acc);
                    acc = MFMA16(cat4(vtr(wp + 32 * P), vtr(wp + 48 * P)), Sb1, acc);
                    const unsigned long long uu = *(const LAS unsigned long long*)(Ub + e * UPB + 2 * (16 * t4 + 4 * g));
                    const f32x4v u = {__builtin_bit_cast(float, (unsigned)uu << 16), __builtin_bit_cast(float, (unsigned)uu & 0xffff0000u), __builtin_bit_cast(float, (unsigned)(uu >> 32) << 16), __builtin_bit_cast(float, (unsigned)(uu >> 32) & 0xffff0000u)};
                    vn[t4] = u - acc;
                }
                vb0 = pack8(vn[0][0], vn[0][1], vn[0][2], vn[0][3], vn[1][0], vn[1][1], vn[1][2], vn[1][3]);
                vb1 = pack8(vn[2][0], vn[2][1], vn[2][2], vn[2][3], vn[3][0], vn[3][1], vn[3][2], vn[3][3]);
                f32x4v el[4];
#pragma unroll
                for (int t4 = 0; t4 < 4; ++t4) el[t4] = *(const LAS f32x4v*)(ELb + 4 * (16 * t4 + 4 * g));
                vs0 = pack8(vn[0][0] * el[0][0], vn[0][1] * el[0][1], vn[0][2] * el[0][2], vn[0][3] * el[0][3], vn[1][0] * el[1][0], vn[1][1] * el[1][1], vn[1][2] * el[1][2], vn[1][3] * el[1][3]);
                vs1 = pack8(vn[2][0] * el[2][0], vn[2][1] * el[2][1], vn[2][2] * el[2][2], vn[2][3] * el[2][3], vn[3][0] * el[3][0], vn[3][1] * el[3][1], vn[3][2] * el[3][2], vn[3][3] * el[3][3]);
            }
            if (it < 32 && wave == 3) { CDN_IDS(); kk_tile(lds, p, MF1, 8, lane); kk_tile(lds, p, MF1, 9, lane); }
        }
        __syncthreads();
        CDN_IDS();
        if (wave < 4 && it >= 1) {
            {   const int n = it - 1;
                const LAS unsigned char* Qb = lds + QS2 + q * 9216; const LAS unsigned char* Ab = lds + AS2 + q * 9216; const LAS unsigned char* EGb = lds + EG2 + q * 256;
                const int c = dir ? 31 - n : n;
#pragma unroll
                for (int t4 = 0; t4 < 4; ++t4) {
                    const LAS unsigned char* qp = Qb + (16 * t4 + l15) * P + 8 * g; const LAS unsigned char* ap = Ab + (4 * g + (l15 >> 2)) * P + (16 * t4 + 4 * (l15 & 3)) * 2;
                    f32x4v acc = (f32x4v){0.f, 0.f, 0.f, 0.f};
                    acc = MFMA16(Sb0, ld44(qp, qp + 32), acc);
                    acc = MFMA16(Sb1, ld44(qp + 64, qp + 96), acc);
                    const float egi = *(const LAS float*)(EGb + 4 * (16 * t4 + l15));
                    acc = acc * egi;
                    acc = MFMA16(vb0, cat4(vtr(ap), vtr(ap + 16 * P)), acc);
                    acc = MFMA16(vb1, cat4(vtr(ap + 32 * P), vtr(ap + 48 * P)), acc);
                    {   const int i = 16 * t4 + l15; const size_t tok = rowbase + 64 * c + (dir ? 63 - i : i);
                        *(unsigned long long*)(OUT + tok * opitch + 16 * wave + 4 * g) = (unsigned long long)cvtpk(acc[0], acc[1]) | ((unsigned long long)cvtpk(acc[2], acc[3]) << 32); }
                }
            }
            const LAS unsigned char* Kb = lds + KS2 + q * 9216; const float egL = *(const LAS float*)(lds + EG2 + q * 256 + 4 * 63);
#pragma unroll
            for (int t = 0; t < 4; ++t) {
                const LAS unsigned char* kp = Kb + (4 * g + (l15 >> 2)) * P + (16 * t + 4 * (l15 & 3)) * 2;
                f32x4v acc = St[t] * egL;
                acc = MFMA16(cat4(vtr(kp), vtr(kp + 16 * P)), vs0, acc);
                acc = MFMA16(cat4(vtr(kp + 32 * P), vtr(kp + 48 * P)), vs1, acc);
                St[t] = acc;
            }
        }
        if (it < 32 && (wave == 4 || wave == 5)) {
            const int B = wave - 4;
            if (lane < 32) {
                float x[16];
                const LAS float* mf = (const LAS float*)(lds + MF1) + B * 1024 + (g & 1) * (16 * 32 + 16);
                f32x4v mq[36];
#pragma unroll
                for (int r = 1; r < 16; ++r)
#pragma unroll
                    for (int k4 = 0; k4 * 4 < r; ++k4) mq[sub_qoff(r) + k4] = *(const LAS f32x4v*)(mf + r * 32 + 4 * k4);
                asm volatile("s_waitcnt lgkmcnt(0)" ::: "memory");
#define CDN_FNMA(a, mm, xx) asm("v_fma_f32 %0, -%1, %2, %0" : "+v"(a) : "v"(mm), "v"(xx))
#pragma unroll
                for (int r = 0; r < 16; ++r) {
                    float a0 = (r == l15) ? 1.f : 0.f, a1 = 0.f, a2 = 0.f, a3 = 0.f;
#pragma unroll
                    for (int k4 = 0; k4 * 4 < r; ++k4) { const f32x4v mr = mq[sub_qoff(r) + k4];
                        if (4 * k4 + 0 < r) CDN_FNMA(a0, mr[0], x[4 * k4 + 0]); if (4 * k4 + 1 < r) CDN_FNMA(a1, mr[1], x[4 * k4 + 1]); if (4 * k4 + 2 < r) CDN_FNMA(a2, mr[2], x[4 * k4 + 2]); if (4 * k4 + 3 < r) CDN_FNMA(a3, mr[3], x[4 * k4 + 3]); }
                    x[r] = (a0 + a1) + (a2 + a3);
                }
#undef CDN_FNMA
                const int jc0 = 32 * B + lane; const float eg0 = *(const LAS float*)(lds + EG2 + p * 256 + 4 * jc0);
#pragma unroll
                for (int r = 0; r < 16; ++r) { const int i = 32 * B + 16 * (g & 1) + r; st_bf2(lds + TS1 + i * P + 2 * jc0, lds + TES1 + i * P + 2 * jc0, x[r], x[r] * eg0); }
            }
            const bool valid = r32 < 16;
            f32x16 zero;
#pragma unroll
            for (int r = 0; r < 16; ++r) zero[r] = 0.f;
            bf16x8 af = ld8(lds + MS1 + (32 * B + 16 + l15) * P + (32 * B + 8 * hi) * 2);
            if (!valid) af = (bf16x8){0, 0, 0, 0, 0, 0, 0, 0};
            const LAS unsigned char* tp = lds + TS1 + (32 * B + 8 * hi + (l15 >> 2)) * P + (32 * B + 16 * ((lane >> 4) & 1) + 4 * (lane & 3)) * 2;
            const bf16x8 bf = cat4(vtr(tp), vtr(tp + 4 * P));
            const f32x16 X = MFMA32(af, bf, zero);
            const LAS unsigned char* t11 = lds + TS1 + (32 * B + 16 + l15) * P + (32 * B + 16 + 4 * hi) * 2;
            bf16x8 a2 = ld44(t11, t11 + 16);
            if (!valid) a2 = (bf16x8){0, 0, 0, 0, 0, 0, 0, 0};
            const f32x16 Y = MFMA32(a2, pack8(X[0], X[1], X[2], X[3], X[4], X[5], X[6], X[7]), zero);
            const int jc = 32 * B + r32; const float egj = *(const LAS float*)(lds + EG2 + p * 256 + 4 * (jc & 63));
            if (valid) {
#pragma unroll
                for (int r = 0; r < 8; ++r) { const int i = 32 * B + 16 + crow(r, hi); st_bf2(lds + TS1 + i * P + 2 * jc, lds + TES1 + i * P + 2 * jc, -Y[r], -Y[r] * egj); }
            }
        }
        __syncthreads();
        CDN_IDS();
        if (it < 32 && wave < 3) {
                const int I = wave > 0, J = wave > 1;
                f32x16 acc;
#pragma unroll
                for (int r = 0; r < 16; ++r) acc[r] = 0.f;
                const LAS unsigned char* ap = lds + QS2 + p * 9216 + (32 * I + r32) * P + 16 * hi; const LAS unsigned char* bp = lds + KS2 + p * 9216 + (32 * J + r32) * P + 16 * hi;
#pragma unroll
                for (int s = 0; s < 4; ++s) acc = MFMA32(ld8(ap + 32 * s), ld8(bp + 32 * s), acc);
                const int j = 32 * J + r32; const float gcj = *(const LAS float*)(lds + GC2 + p * 256 + 4 * j);
#pragma unroll
                for (int q4 = 0; q4 < 4; ++q4) {
                    const int i0 = 32 * I + 8 * q4 + 4 * hi; const f32x4v gci = *(const LAS f32x4v*)(lds + GC2 + p * 256 + 4 * i0);
                    float av[4];
#pragma unroll
                    for (int e = 0; e < 4; ++e) { const int i = i0 + e; av[e] = (i >= j) ? acc[4 * q4 + e] * __builtin_amdgcn_exp2f(gci[e] - gcj) : 0.f; }
                    *(LAS unsigned long long*)(lds + AS2 + p * 9216 + j * P + 2 * i0) = (unsigned long long)cvtpk(av[0], av[1]) | ((unsigned long long)cvtpk(av[2], av[3]) << 32);
                }
            }
        if (it + 1 < 32) { CDN_STAGE(q); if (it + 2 < 32) CDN_PREFETCH(it + 2); }
        if (it < 32 && wave >= 4) {
            const int ct = wave - 4; const int R = ct < 2 ? VS2 + p * 9216 : KS2 + p * 9216, coff = 32 * (ct & 1), TA = ct < 2 ? TS1 : TES1;
            const LAS unsigned char* rp = lds + R + (8 * hi + (l15 >> 2)) * P + (coff + 16 * ((lane >> 4) & 1) + 4 * (lane & 3)) * 2;
            f32x16 X0, Y, Z;
#pragma unroll
            for (int r = 0; r < 16; ++r) { X0[r] = 0.f; Y[r] = 0.f; Z[r] = 0.f; }
#pragma unroll
            for (int s = 0; s < 2; ++s) X0 = MFMA32(ld8(lds + TA + r32 * P + (16 * s + 8 * hi) * 2), cat4(vtr(rp + 16 * s * P), vtr(rp + (16 * s + 4) * P)), X0);
#pragma unroll
            for (int s = 0; s < 2; ++s) Z = MFMA32(ld8(lds + TA + (32 + r32) * P + (32 + 16 * s + 8 * hi) * 2), cat4(vtr(rp + (32 + 16 * s) * P), vtr(rp + (32 + 16 * s + 4) * P)), Z);
            { const LAS unsigned char* mp = lds + MS1 + (32 + r32) * P + 8 * hi;
              Y = MFMA32(ld44(mp, mp + 16), pack8(X0[0], X0[1], X0[2], X0[3], X0[4], X0[5], X0[6], X0[7]), Y);
              Y = MFMA32(ld44(mp + 32, mp + 48), pack8(X0[8], X0[9], X0[10], X0[11], X0[12], X0[13], X0[14], X0[15]), Y); }
            { const LAS unsigned char* t1 = lds + TS1 + (32 + r32) * P + 64 + 8 * hi;
              Z = MFMA32(ld44(t1, t1 + 16), pack8(-Y[0], -Y[1], -Y[2], -Y[3], -Y[4], -Y[5], -Y[6], -Y[7]), Z);
              Z = MFMA32(ld44(t1 + 32, t1 + 48), pack8(-Y[8], -Y[9], -Y[10], -Y[11], -Y[12], -Y[13], -Y[14], -Y[15]), Z); }
            const int col = coff + r32;
#pragma unroll
            for (int half = 0; half < 2; ++half)
#pragma unroll
                for (int q4 = 0; q4 < 4; ++q4) {
                    const int i0 = 32 * half + 8 * q4 + 4 * hi; const f32x4v bi = *(const LAS f32x4v*)(lds + BETA2 + p * 256 + 4 * i0);
                    f32x4v v;
#pragma unroll
                    for (int e = 0; e < 4; ++e) v[e] = (half ? Z[4 * q4 + e] : X0[4 * q4 + e]) * bi[e];
                    if (ct < 2) *(LAS unsigned long long*)(lds + US2 + p * 64 * UPB + col * UPB + 2 * i0) = (unsigned long long)cvtpk(v[0], v[1]) | ((unsigned long long)cvtpk(v[2], v[3]) << 32);
                    else *(LAS unsigned long long*)(lds + WS2 + p * 9216 + col * P + 2 * i0) = (unsigned long long)cvtpk(v[0], v[1]) | ((unsigned long long)cvtpk(v[2], v[3]) << 32);
                }
        }
        __syncthreads();
    }
#undef CDN_PREFETCH
#undef CDN_STAGE
#undef CDN_IDS
}

__device__ __forceinline__ void finalize_bc(int gtid, int nthreads, unsigned char* ws, unsigned char* xs, const float* outg, bf16* OBb, bf16* OBc, int opitch) {
    bf16* QO = (bf16*)(ws + WS_QO);
    const bf16 *P0 = (const bf16*)(ws + WS_P0), *P1 = (const bf16*)(ws + WS_P1), *P2 = (const bf16*)(ws + WS_P2);
    const float *L0 = (const float*)(xs + XS_L0), *L1 = (const float*)(xs + XS_L1), *L2 = (const float*)(xs + XS_L2);
    const bf16 *CF = (const bf16*)(ws + WS_CF), *CZ = (const bf16*)(ws + WS_CZ);
    constexpr int UN = 3;
    static_assert((MT * 48) % UN == 0, "finalize");
#pragma unroll 1
    for (int i0 = gtid; i0 < MT * 48; i0 += UN * nthreads) {
        v4u a[UN], bq[UN], c[UN], f[UN], bw[UN], z[UN]; float l[UN];
#pragma unroll
        for (int k = 0; k < UN; ++k) { const int i = i0 + k * nthreads; const bool ok = i < MT * 48; const int ii = ok ? i : gtid; const int row = ii / 48, c8 = ii % 48, h = c8 >> 3;
            l[k] = L0[(size_t)row * 6 + h] + L1[(size_t)row * 6 + h] + L2[(size_t)row * 6 + h];
            a[k] = *(const v4u*)(P0 + (size_t)row * 384 + c8 * 8); bq[k] = *(const v4u*)(P1 + (size_t)row * 384 + c8 * 8); c[k] = *(const v4u*)(P2 + (size_t)row * 384 + c8 * 8);
            f[k] = *(const v4u*)(CF + (size_t)row * 384 + c8 * 8); bw[k] = *(const v4u*)(QO + (size_t)row * 1024 + 640 + c8 * 8); z[k] = *(const v4u*)(CZ + (size_t)row * 384 + c8 * 8); }
#pragma unroll
        for (int k = 0; k < UN; ++k) { const int i = i0 + k * nthreads; const bool ok = i < MT * 48; const int ii = ok ? i : gtid; const int row = ii / 48, c8 = ii % 48;
            {
                const float rl = 1.0f / l[k]; v4u o;
#pragma unroll
                for (int e = 0; e < 4; ++e) {
                    const float lo = (__builtin_bit_cast(float, a[k][e] << 16) + __builtin_bit_cast(float, bq[k][e] << 16) + __builtin_bit_cast(float, c[k][e] << 16)) * rl;
                    const float hi2 = (__builtin_bit_cast(float, a[k][e] & 0xffff0000u) + __builtin_bit_cast(float, bq[k][e] & 0xffff0000u) + __builtin_bit_cast(float, c[k][e] & 0xffff0000u)) * rl;
                    o[e] = pk2(lo, hi2);
                }
                if (ok) *(v4u*)(OBb + (size_t)row * opitch + c8 * 8) = o;
            }
            {
                float t[8]; float ss = 0.f;
#pragma unroll
                for (int e = 0; e < 4; ++e) { t[2 * e] = __builtin_bit_cast(float, f[k][e] << 16) + __builtin_bit_cast(float, bw[k][e] << 16); t[2 * e + 1] = __builtin_bit_cast(float, f[k][e] & 0xffff0000u) + __builtin_bit_cast(float, bw[k][e] & 0xffff0000u);
                    ss += t[2 * e] * t[2 * e] + t[2 * e + 1] * t[2 * e + 1]; }
                ss += __shfl_xor(ss, 1); ss += __shfl_xor(ss, 2); ss += __shfl_xor(ss, 4);
                const float rs = __builtin_amdgcn_rsqf(ss * (1.0f / 64.0f) + 1e-6f);
                const float* gp = outg + (c8 & 7) * 8;
                v4u o;
#pragma unroll
                for (int e = 0; e < 4; ++e) o[e] = pk2(t[2 * e] * rs * gp[2 * e] * __builtin_bit_cast(float, z[k][e] << 16), t[2 * e + 1] * rs * gp[2 * e + 1] * __builtin_bit_cast(float, z[k][e] & 0xffff0000u));
                if (ok) *(v4u*)(OBc + (size_t)row * opitch + c8 * 8) = o;
            }
        }
    }
}
}
#define XB_TMO      128
#define XB_XCNT(j)  (256  + 64 * (j))
#define XB_XSUB(j)  (1280 + 64 * (j))
#define XB_XGEN(j)  (2304 + 64 * (j))
#define XB_TOP      3328
#define XB_TOPGEN   3392
#define XCD_BAR_WORDS 3456
#define XB_SPIN_CAP (1u << 24)

__device__ __forceinline__ unsigned xb_ld(unsigned* p)              { return __hip_atomic_load(p, __ATOMIC_RELAXED, __HIP_MEMORY_SCOPE_AGENT); }
__device__ __forceinline__ unsigned xb_add(unsigned* p, unsigned v) { return __hip_atomic_fetch_add(p, v, __ATOMIC_RELAXED, __HIP_MEMORY_SCOPE_AGENT); }
__device__ __forceinline__ unsigned xb_xcc_id() { return (unsigned)__builtin_amdgcn_s_getreg((3 << 11) | 20) & 0xFu; }
#define XB_SPIN(cond, bar) do { unsigned _sp = 0; while (cond) { __builtin_amdgcn_s_sleep(1); \
    if ((++_sp & 255u) == 0u) { if (xb_ld(&(bar)[XB_TMO])) break; if (_sp > XB_SPIN_CAP) { atomicAdd(&(bar)[XB_TMO], 1u); break; } } } } while (0)

struct XcdBarrier {
    unsigned* bar; unsigned x;
    volatile LAS unsigned* st;
};

__device__ __forceinline__ XcdBarrier xcd_barrier_post(unsigned* bar, volatile LAS unsigned* st) {
    XcdBarrier b; b.bar = bar; b.x = xb_xcc_id(); b.st = st;
    if (threadIdx.x == 0) (void)xb_add(&bar[XB_XCNT(b.x)], 1u);
    return b;
}
__device__ __forceinline__ void xcd_barrier_complete(unsigned* bar, unsigned x, unsigned& nloc, unsigned& nx) {
    const unsigned G = gridDim.x * gridDim.y * gridDim.z;
    unsigned sum, cnt, mine, sp = 0u;
    for (;;) {
        sum = 0u; cnt = 0u; mine = 0u;
#pragma unroll
        for (unsigned j = 0; j < 16; ++j) { const unsigned c = xb_ld(&bar[XB_XCNT(j)]); sum += c; cnt += (c > 0u) ? 1u : 0u; mine = (j == x) ? c : mine; }
        if (sum == G) break;
        __builtin_amdgcn_s_sleep(1);
        if ((++sp & 255u) == 0u) { if (xb_ld(&bar[XB_TMO])) break; if (sp > XB_SPIN_CAP) { atomicAdd(&bar[XB_TMO], 1u); break; } }
    }
    nloc = mine > 0u ? mine : 1u; nx = cnt > 0u ? cnt : 1u;
}

__device__ __forceinline__ void xcd_barrier(const XcdBarrier& b) {
    asm volatile("s_waitcnt vmcnt(0)" ::: "memory");
    __syncthreads();
    if (threadIdx.x == 0) {
        unsigned* bar = b.bar;
        __builtin_amdgcn_s_waitcnt(0);
        unsigned nloc = b.st[0], nx = b.st[1];
        if (nloc == 0u) { xcd_barrier_complete(bar, b.x, nloc, nx); b.st[0] = nloc; b.st[1] = nx; }
        const unsigned old = xb_add(&bar[XB_XSUB(b.x)], 1u);
        const unsigned gen = old / nloc;
        if (old + 1u == (gen + 1u) * nloc) {
            __builtin_amdgcn_fence(__ATOMIC_RELEASE, "agent");
            asm volatile("s_waitcnt vmcnt(0)" ::: "memory");
            const unsigned og = xb_add(&bar[XB_TOP], 1u);
            const unsigned tg = og / nx;
            if (og + 1u == (tg + 1u) * nx) xb_add(&bar[XB_TOPGEN], 1u);
            else XB_SPIN(xb_ld(&bar[XB_TOPGEN]) == tg, bar);
            __builtin_amdgcn_fence(__ATOMIC_ACQUIRE, "agent");
            xb_add(&bar[XB_XGEN(b.x)], 1u);
            asm volatile("s_waitcnt vmcnt(0)" ::: "memory");
        } else {
            XB_SPIN(xb_ld(&bar[XB_XGEN(b.x)]) == gen, bar);
            __builtin_amdgcn_fence(__ATOMIC_ACQUIRE, "agent");
            asm volatile("s_waitcnt vmcnt(0)" ::: "memory");
        }
    }
    __syncthreads();
}
constexpr int RING_BYTES = 139264, LDSCTL_OFF = RING_BYTES, MISC_OFF = LDSCTL_OFF + 320, LDS_BYTES = 147456;
constexpr int CW_TMO = 0, CW_BAR = 4096;
typedef GAS unsigned gu32;
#define RLX_AGENT __ATOMIC_RELAXED, __HIP_MEMORY_SCOPE_AGENT
#ifndef PROBE_MASK
#define PROBE_MASK 0
#endif
constexpr int popc9(int m) { int c = 0; for (int k = 0; k < 9; ++k) c += (m >> k) & 1; return c; }
constexpr int PH_PER_LAYER = 9 + popc9(PROBE_MASK), NPHASE = 1 + PH_PER_LAYER * DEPTH;
__device__ __forceinline__ int dup_at(int p) { int q = 0; for (int k = 0; k < 9; ++k) { const int n = 1 + ((PROBE_MASK >> k) & 1); if (p < q + n) return p - q; q += n; } return 0; }
#ifndef PROBE_SUB
#define PROBE_SUB 0
#endif
__device__ __forceinline__ int kind_at(int p) { int q = 0; for (int k = 0; k < 9; ++k) { const int n = 1 + ((PROBE_MASK >> k) & 1); if (p < q + n) return k; q += n; } return 8; }

__device__ __forceinline__ int mk_lane_id() { int l; asm volatile("v_mbcnt_lo_u32_b32 %0, -1, 0\n\tv_mbcnt_hi_u32_b32 %0, -1, %0" : "=v"(l)); return l; }
__global__ void __launch_bounds__(512, 2) mk_fwd(MKArgs a) {
    extern __shared__ __attribute__((aligned(16))) unsigned char lds_raw[];
    LAS unsigned char* lds = (LAS unsigned char*)lds_raw;
    volatile LAS unsigned* MISC = (volatile LAS unsigned*)(lds + MISC_OFF);
    const int tid0 = threadIdx.x;
    const int wave0 = __builtin_amdgcn_readfirstlane(tid0 >> 6);
    const int G = gridDim.x;
    unsigned char* ws = a.ws;
    for (int u = tid0; u < (LDS_BYTES - LDSCTL_OFF) / 4; u += 512) ((LAS unsigned*)(lds + LDSCTL_OFF))[u] = 0u;
    __syncthreads();
    const int lo = a.ph_lo, hi = a.ph_hi;
    XcdBarrier bar = xcd_barrier_post((unsigned*)(ws + WS_CTL) + CW_BAR + lo * 4096, MISC + 8);
#pragma unroll 1
    for (int ph = lo; ph < hi; ++ph) {
#define MK_TID() (wave0 * 64 + mk_lane_id())
        const int wave = wave0;
        int bid = blockIdx.x; asm volatile("" : "+s"(bid));
        const int l = ph == 0 ? 0 : (ph - 1) / PH_PER_LAYER, kind = ph == 0 ? -1 : kind_at((ph - 1) % PH_PER_LAYER);
        bf16* HB = (bf16*)(ws + WS_HB); bf16* HID = (bf16*)(ws + WS_HID);
        unsigned char* wl = ws + WS_W + (size_t)l * W_LAYER;
        const float* pb = (const float*)(ws + WS_PB) + l * PB_LAYER;
        if (kind == -1) {
#ifndef PROBE_PRO
#define PROBE_PRO 0
#endif
#pragma unroll 1
            for (int rep = 0; rep <= PROBE_PRO; ++rep)
            prologue_phase((const CAS cfp*)__builtin_amdgcn_kernarg_segment_ptr(), ws, lds, bid * 8 + wave, G * 8, wave, mk_lane_id());
        } else if (kind == 0 || kind == 7) {
            pg8::Gemm g{HB, (const bf16*)(wl + (kind ? OFF_GU2 : OFF_GU1)), MT, NGU, DM}; pg8::SplitOrder S; S.init(MT, NGU, G, bid);
            pg8::EpiSwiGLU E{ws, DFF, 0}; E.tbl = pg8::fill_rstd(lds, S, (const float*)(ws + WS_SSQ), MK_TID(), 8);
            pg8::gemm_phase<pg8::EpiSwiGLU, pg8::SplitOrder, true, true, true>(lds, g, S, E, MK_TID());
        } else if (kind == 1 || kind == 8) {
            pg8::Gemm g{HID, (const bf16*)(wl + (kind == 8 ? OFF_D2 : OFF_D1)), MT, DM, DFF}; pg8::StaticOrder S; S.init(MT, DM, G, bid);
            pg8::EpiResid E{(l == 0 && kind == 1) ? a.in[0] : nullptr, (l == DEPTH - 1 && kind == 8) ? a.out : nullptr, ws, 0.5f, 0};
            pg8::gemm_phase<pg8::EpiResid, pg8::StaticOrder, true, true>(lds, g, S, E, MK_TID());
        } else if (kind == 2) {
            pg8::Gemm g{HB, (const bf16*)(wl + OFF_IN), MT, NIN_MAIN, DM}; pg8::StaticOrder S; S.init(MT, NIN_MAIN, G, bid);
            pg8::EpiInProj E{ws, l, 0, 0}; pg8::fill_params<int>(lds, pb, MK_TID()); E.tbl = pg8::fill_rstd(lds, S, (const float*)(ws + WS_SSQ), MK_TID(), 6);
            pg8::gemm_phase<pg8::EpiInProj, pg8::StaticOrder, true, true>(lds, g, S, E, MK_TID());
        } else if (kind == 3) {
#pragma unroll 1
            for (int it = bid * 8 + wave; it < 256 * 18; it += G * 8) cdn::prep_item(it, mk_lane_id(), ws, (unsigned char*)a.out, pb + PB_CONV);
            if (l == 0) {   const float refA = pb[PB_REFA];
#pragma unroll 1
                for (int ia = bid; ia < 256; ia += G) att::itemA(lds, ia, MK_TID(), ws, refA, (bf16*)(ws + WS_QO), 1024);
            }
        } else if (kind == 4) {
            const float refB = pb[PB_REFB]; const float* tbg = (const float*)(ws + WS_PB) + PB_TB;
            const int isdup = dup_at((ph - 1) % PH_PER_LAYER); const bool do_scan = !(isdup && PROBE_SUB == 2), do_b = !(isdup && PROBE_SUB == 1);
            if (do_scan) {
#pragma unroll 1
            for (int it = bid; it < 96; it += G) cdn::scan_item(lds, it, MK_TID(), ws, (unsigned char*)a.out);
            }
            const int nbw = G > 96 ? G - 96 : G, st = G > 96 ? bid - 96 : bid;
            if (st >= 0 && do_b) {
                {
                    pg8::Gemm g{HB, (const bf16*)(wl + OFF_IN) + (size_t)NIN_MAIN * DM, MT, 256, DM}; pg8::StaticOrder S; S.init(MT, 256, nbw > 96 ? nbw - 96 : nbw, nbw > 96 ? (st >= 96 ? st - 96 : 1 << 20) : st);
                    pg8::EpiInProj E{ws, l, 48, 0}; pg8::fill_params<int>(lds, pb, MK_TID()); E.tbl = pg8::fill_rstd(lds, S, (const float*)(ws + WS_SSQ), MK_TID(), 6);
                    pg8::gemm_phase<pg8::EpiInProj, pg8::StaticOrder, true, true>(lds, g, S, E, MK_TID());
                }
                if (l != 0) { const float refA = pb[PB_REFA];
#pragma unroll 1
                    for (int ia = st; ia < 256; ia += nbw) att::itemA(lds, ia, MK_TID(), ws, refA, (bf16*)(ws + WS_QO), 1024); }
                att::fill_tables(lds, tbg, MK_TID());
                {   bf16* const Pb[3] = {(bf16*)(ws + WS_P0), (bf16*)(ws + WS_P1), (bf16*)(ws + WS_P2)};
                    float* const Lb[3] = {(float*)((unsigned char*)a.out + XS_L0), (float*)((unsigned char*)a.out + XS_L1), (float*)((unsigned char*)a.out + XS_L2)};
#pragma unroll 1
                    for (int ib = st; ib < 768; ib += nbw) att::itemB(lds, ib, MK_TID(), ws, refB, Pb, Lb);
                }
                if (l == 0 && dup_at((ph - 1) % PH_PER_LAYER) == 0)
                    convert_weights((const CAS cfp*)__builtin_amdgcn_kernarg_segment_ptr(), ws, lds, st * 8 + wave, nbw * 8, wave, mk_lane_id(), 1);
            }
        } else if (kind == 5) {
            const bool scr5 = (PROBE_MASK & 32) && dup_at((ph - 1) % PH_PER_LAYER) == 0;
            cdn::finalize_bc(bid * 512 + MK_TID(), G * 512, ws, (unsigned char*)a.out, pb + PB_OUTG, scr5 ? (bf16*)(ws + WS_VC) : (bf16*)(ws + WS_QO) + 256, scr5 ? (bf16*)(ws + WS_VC) : (bf16*)(ws + WS_QO) + 640, scr5 ? 384 : 1024);
        } else {
            pg8::Gemm g{(const bf16*)(ws + WS_QO), (const bf16*)(wl + OFF_O), MT, DM, DM}; pg8::StaticOrder S; S.init(MT, DM, G, bid);
            pg8::EpiResid E{nullptr, nullptr, ws, 1.0f, 0};
            pg8::gemm_phase<pg8::EpiResid, pg8::StaticOrder, true, true>(lds, g, S, E, MK_TID());
        }
        if (ph + 1 < hi) xcd_barrier(bar);
    }
}

extern "C" void kernel_launch(void* const* d_in, const int* in_sizes, int n_in, void* d_out, int out_size, void* d_ws, size_t ws_size, hipStream_t stream) {
    static int grid = 0;
    if (grid == 0) {
        if (n_in != 21 || out_size != MT * DM || ws_size < WS_END) { fprintf(stderr, "kernel_launch: unexpected problem shape (n_in %d out %d ws %zu)\n", n_in, out_size, ws_size); grid = -1; return; }
        int dev = 0, cus = 0, per_cu = 0;
        if (hipGetDevice(&dev) != hipSuccess || hipDeviceGetAttribute(&cus, hipDeviceAttributeMultiprocessorCount, dev) != hipSuccess) { grid = -1; return; }
        if (hipFuncSetAttribute((const void*)mk_fwd, hipFuncAttributeMaxDynamicSharedMemorySize, LDS_BYTES) != hipSuccess) { fprintf(stderr, "kernel_launch: hipFuncSetAttribute failed\n"); grid = -1; return; }
        if (hipOccupancyMaxActiveBlocksPerMultiprocessor(&per_cu, (const void*)mk_fwd, 512, LDS_BYTES) != hipSuccess || per_cu < 1) { fprintf(stderr, "kernel_launch: occupancy query says %d\n", per_cu); per_cu = 1; }
        (void)hipGetLastError();
        grid = cus;
    }
    if (grid < 0) return;
    (void)hipMemsetAsync((char*)d_ws + WS_CTL, 0, WS_PB, stream);
    MKArgs a; memset(&a, 0, sizeof a);
    for (int i = 0; i < 21; ++i) a.in[i] = (const float*)d_in[i];
    a.out = (float*)d_out; a.ws = (unsigned char*)d_ws;
    a.ph_lo = 0; a.ph_hi = NPHASE;
    hipLaunchKernelGGL(mk_fwd, dim3(grid), dim3(512), LDS_BYTES, stream, a);
}
```

```cpp
#include <hip/hip_runtime.h>
#include <cstdio>
#include <cstdint>
#include <cstring>
constexpr int BATCH = 8, SEQ = 2048, DM = 1024, MT = BATCH * SEQ, DFF = 2816, NIN = 3224, NINP = 3328, NIN_MAIN = 3072, DEPTH = 2;
constexpr int NGU = 2 * DFF;
typedef unsigned short bf16;
typedef unsigned v4u __attribute__((ext_vector_type(4)));
typedef float f32x4 __attribute__((ext_vector_type(4)));
#define LAS __attribute__((address_space(3)))
#define GAS __attribute__((address_space(1)))

constexpr size_t MiB = 1u << 20;
constexpr size_t WS_CTL = 0, CTL_BYTES = 1 * MiB;
constexpr size_t WS_PB = 512 * 1024;
constexpr int PB_AQN = 0, PB_AKN = 64, PB_BQN = 128, PB_BKN = 192, PB_OUTG = 256, PB_ALOG = 320, PB_DTB = 332, PB_REFA = 344, PB_REFB = 345, PB_CONV = 384, PB_LAYER = 6144, PB_REL = 2 * PB_LAYER, PB_TB = PB_REL + 192, PB_FLOATS = PB_TB + 6 * 3 * 136;
constexpr size_t WS_SSQ = 1 * MiB;
constexpr size_t WS_W = 2 * MiB;
constexpr size_t W_GU = (size_t)NGU * DM * 2, W_D = (size_t)DM * DFF * 2, W_IN = (size_t)NINP * DM * 2, W_O = (size_t)DM * DM * 2;
constexpr size_t OFF_GU1 = 0, OFF_D1 = OFF_GU1 + W_GU, OFF_IN = OFF_D1 + W_D, OFF_O = OFF_IN + W_IN, OFF_GU2 = OFF_O + W_O, OFF_D2 = OFF_GU2 + W_GU, W_LAYER = OFF_D2 + W_D;
static_assert(W_LAYER * 2 == 83 * MiB, "weights");
constexpr size_t WS_HB = 85 * MiB;
constexpr size_t WS_R = 117 * MiB;
constexpr size_t WS_HID = WS_R;
constexpr size_t WS_QO = WS_R, WS_KA = WS_QO + 32 * MiB, WS_VA = WS_KA + 4 * MiB, WS_KB = WS_VA + 4 * MiB, WS_VB = WS_KB + 12 * MiB, WS_CR = WS_VB + 12 * MiB,
                 WS_CZ = WS_CR + 36 * MiB, WS_GT = WS_CZ + 12 * MiB, WS_VC = WS_GT + 2 * MiB, WS_CF = WS_VC + 12 * MiB, WS_END = WS_CF + 12 * MiB;
constexpr size_t WS_P0 = WS_CR, WS_P1 = WS_CR + 12 * MiB, WS_P2 = WS_CR + 24 * MiB;
constexpr size_t XS_QN = 0, XS_KN = 12 * MiB, XS_L0 = 24 * MiB, XS_L1 = XS_L0 + 512 * 1024, XS_L2 = XS_L1 + 512 * 1024;
static_assert(WS_END <= 256 * MiB && WS_HID + (size_t)MT * DFF * 2 <= 256 * MiB, "d_ws map");

namespace pg8 {
#define PG8_LAS __attribute__((address_space(3)))
typedef unsigned short bf16_t;
typedef short bf16x8 __attribute__((ext_vector_type(8)));
typedef float f32x4 __attribute__((ext_vector_type(4)));
typedef unsigned u32x4 __attribute__((ext_vector_type(4)));
constexpr int BM = 256, BK = 64, HALF = 128, HTB = HALF * BK * 2  , STAGE_BYTES = 8 * HTB, NXCD = 8, WGM = 8;

__host__ __device__ __forceinline__ int lds_byte(int r, int c) { const int st = (r >> 4) * 2 + (c >> 5), rr = r & 15, cc = c & 31, ob = rr * 64 + cc * 2; return st * 1024 + (ob ^ (((ob >> 9) & 1) << 5)); }
__host__ __device__ __forceinline__ void stage_rc(int b, int& R, int& C) { const int st = b / 1024, sb = b % 1024, swz = sb ^ (((sb >> 9) & 1) << 5); R = (st >> 1) * 16 + swz / 64; C = (st & 1) * 32 + (swz % 64) / 2; }
__host__ __device__ __forceinline__ int perm32(int rho) { const int n = rho >> 4, i = rho & 15; return 8 * (i >> 2) + 4 * n + (i & 3); }

struct Unit { int pm, pn, hm; };
struct Gemm { const bf16_t* A; const bf16_t* Bt; int M, N, K; };

struct StaticOrder {
    int nM, nN, nwg, G, c;
    __host__ __device__ void init(int M, int N, int G_, int c_) { nM = M / BM; nN = N / BM; nwg = nM * nN; G = G_; c = c_; }
    __host__ __device__ bool next(int i, Unit& u) const {
        const long L = (long)i * G + c; if (L >= nwg) return false;
        int wgid = (int)L; { const int q = nwg / NXCD, r = nwg % NXCD, xcd = wgid % NXCD, off = wgid / NXCD; wgid = (xcd < r ? xcd * (q + 1) : r * (q + 1) + (xcd - r) * q) + off; }
        const int nig = WGM * nN, gid = wgid / nig, fm = gid * WGM, gsz = (nM - fm) < WGM ? (nM - fm) : WGM;
        u.pm = fm + ((wgid % nig) % gsz); u.pn = (wgid % nig) / gsz; u.hm = 0; return true;
    }
    __device__ __forceinline__ void a_ready(const Unit&) const {}
    __device__ __forceinline__ void done(const Unit&) const {}
};
struct SplitOrder {
    int nM, nN, nwg, G, c, fullr; bool split, hfirst;
    __host__ __device__ __forceinline__ void init(int M, int N, int G_, int c_) { nM = M / BM; nN = N / BM; nwg = nM * nN; G = G_; c = c_; fullr = nwg / G; split = ((nwg % G) * 2 == G) && (G % (2 * NXCD) == 0) && (nwg % NXCD == 0);
        hfirst = false && split && (((c / NXCD) >> 1) & 1); }
    __host__ __device__ __forceinline__ bool next(int i, Unit& u) const {
        int hm = 0;
        if (split) { if (i > fullr) return false; const int ih = hfirst ? 0 : fullr; if (i == ih) hm = 1 + ((c / NXCD) & 1); else if (hfirst) --i; }
        long L = (long)i * G + c;
        if (hm) L = (long)fullr * G + NXCD * ((c / NXCD) >> 1) + (c % NXCD);
        if (L >= nwg) return false;
        int wgid = (int)L; { const int q = nwg / NXCD, r = nwg % NXCD, xcd = wgid % NXCD, off = wgid / NXCD; wgid = (xcd < r ? xcd * (q + 1) : r * (q + 1) + (xcd - r) * q) + off; }
        const int nig = WGM * nN, gid = wgid / nig, fm = gid * WGM, gsz = (nM - fm) < WGM ? (nM - fm) : WGM;
        u.pm = fm + ((wgid % nig) % gsz); u.pn = (wgid % nig) / gsz; u.hm = hm; return true;
    }
    __device__ __forceinline__ void a_ready(const Unit&) const {}
    __device__ __forceinline__ void done(const Unit&) const {}
};
__device__ __forceinline__ unsigned cvt_pk_bf16(float lo, float hi) { unsigned r; asm volatile("v_cvt_pk_bf16_f32 %0, %1, %2" : "=v"(r) : "v"(lo), "v"(hi)); return r; }
typedef float f32x2 __attribute__((ext_vector_type(2)));
#ifndef PROBE_EPI
#define PROBE_EPI 0
#endif
#ifndef PROBE_EPIX
#define PROBE_EPIX 0
#endif
constexpr float RMS_EPS = 1e-6f;
constexpr int PBL_OFF = 131072 + 6144;
template <class Sched> __device__ __forceinline__ void fill_params(PG8_LAS unsigned char* lds, const float* pbg, int tid) { if (tid < 352) *(PG8_LAS float*)(lds + PBL_OFF + 4 * tid) = pbg[tid]; }
constexpr int RSTD_OFF = 131072;
template <class Sched> __device__ __forceinline__ bool fill_rstd(PG8_LAS unsigned char* lds, const Sched& S, const float* ssq, int tid, int maxu) {
    { Unit u9; if (S.next(maxu, u9)) return false; }
    for (int idx = tid; idx < maxu * 256; idx += 512) { Unit u; if (!S.next(idx >> 8, u)) break;
        const float* p = ssq + (size_t)(u.pm * BM + (idx & 255)) * 16; const f32x4 a = *(const f32x4*)p, b = *(const f32x4*)(p + 4), c = *(const f32x4*)(p + 8), d = *(const f32x4*)(p + 12);
        const float s = (((a[0] + a[1]) + (a[2] + a[3])) + ((b[0] + b[1]) + (b[2] + b[3]))) + (((c[0] + c[1]) + (c[2] + c[3])) + ((d[0] + d[1]) + (d[2] + d[3])));
        *(PG8_LAS float*)(lds + RSTD_OFF + idx * 4) = __builtin_amdgcn_rsqf(s * (1.0f / 1024.0f) + RMS_EPS); }
    __syncthreads();
    return true;
}
__device__ __forceinline__ int pg8_lane_id() { int l; asm volatile("v_mbcnt_lo_u32_b32 %0, -1, 0\n\tv_mbcnt_hi_u32_b32 %0, -1, %0" : "=v"(l)); return l; }
__device__ __forceinline__ float row_rstd(const float* ssq, int row, int fq) {
    const f32x4 p = *(const f32x4*)(ssq + (size_t)row * 16 + 4 * fq);
    float s = (p[0] + p[1]) + (p[2] + p[3]);
    s += __shfl_xor(s, 16); s += __shfl_xor(s, 32);
    return __builtin_amdgcn_rsqf(s * (1.0f / 1024.0f) + RMS_EPS);
}
__device__ __forceinline__ float rstd_of(PG8_LAS unsigned char* lds, const float* ssq, bool tbl, int ui, int lrow, int row, int fq) {
    return tbl ? *(const PG8_LAS float*)(lds + RSTD_OFF + (ui * 256 + lrow) * 4) : row_rstd(ssq, row, fq);
}
__device__ __forceinline__ float silu_f(float x) { return x * __builtin_amdgcn_rcpf(1.0f + __expf(-x)); }

struct EpiSwiGLU {
    static constexpr bool PERM = false, AFTER_DRAIN = false; static constexpr int DUPN = (PROBE_EPI == 1) ? 1 : 0;
    unsigned char* ws; int ldh; int tbl;
    __device__ __forceinline__ void operator()(const f32x4 (&acc)[2][2][4][2], const Unit& u, int wr, int wc, int fr, int fq, int ui, PG8_LAS unsigned char* lds) const {
        asm volatile("" : "+v"(fr), "+v"(fq));
        const int col0 = u.pn * 128 + wc * 32 + 8 * fq;
        const auto hrs = __builtin_amdgcn_make_buffer_rsrc((void*)(ws + WS_HID), 0, MT * DFF * 2, 0x00020000);
        const int hm = u.hm, lr0 = (hm == 2 ? 128 : 0) + wr * (hm ? 32 : 64) + fr, sa = hm ? 64 : 128;
        float rs[2][4];
#pragma unroll
        for (int ai = 0; ai < 2; ++ai)
#pragma unroll
            for (int m = 0; m < 4; ++m) rs[ai][m] = (m < 2 || !hm) ? rstd_of(lds, (const float*)(ws + WS_SSQ), tbl != 0, ui, lr0 + ai * sa + m * 16, u.pm * BM + lr0 + ai * sa + m * 16, fq) : 0.f;
#pragma unroll
        for (int ai = 0; ai < 2; ++ai)
#pragma unroll
            for (int m = 0; m < 4; ++m) if (m < 2 || !hm) {
                const int row = u.pm * BM + lr0 + ai * sa + m * 16;
                const float r = rs[ai][m], nrl = r * -1.4426950408889634f, r2 = r * r;
                f32x4 G0 = acc[ai][0][m][0], G1 = acc[ai][0][m][1], U0 = acc[ai][1][m][0], U1 = acc[ai][1][m][1];
                f32x4 e0 = G0 * nrl, e1 = G1 * nrl;
#pragma unroll
                for (int e = 0; e < 4; ++e) { e0[e] = __builtin_amdgcn_exp2f(e0[e]); e1[e] = __builtin_amdgcn_exp2f(e1[e]); }
                asm volatile("" : "+v"(e0), "+v"(e1));
                f32x4 d0 = e0 + 1.0f, d1 = e1 + 1.0f; const f32x4 p0 = G0 * U0, p1 = G1 * U1;
#pragma unroll
                for (int e = 0; e < 4; ++e) { d0[e] = __builtin_amdgcn_rcpf(d0[e]); d1[e] = __builtin_amdgcn_rcpf(d1[e]); }
                asm volatile("" : "+v"(d0), "+v"(d1));
                const f32x4 h0 = p0 * (d0 * r2), h1 = p1 * (d1 * r2);
                u32x4 w; w.x = cvt_pk_bf16(h0[0], h0[1]); w.y = cvt_pk_bf16(h0[2], h0[3]); w.z = cvt_pk_bf16(h1[0], h1[1]); w.w = cvt_pk_bf16(h1[2], h1[3]);
                __builtin_amdgcn_raw_buffer_store_b128(w, hrs, (unsigned)(row * ldh + col0) * 2u, 0, 16);
                asm volatile("" ::: "memory");
            }
    }
};

struct EpiResid {
    static constexpr bool PERM = false, AFTER_DRAIN = false; static constexpr int DUPN = (PROBE_EPI == 2) ? 1 : 0;
    const float* xin; float* fout; unsigned char* ws; float scale; int pad;
    __device__ __forceinline__ void operator()(const f32x4 (&acc)[2][2][4][2], const Unit& u, int wr, int wc, int fr, int fq, int ui, PG8_LAS unsigned char* lds) const {
        asm volatile("" : "+v"(fr), "+v"(fq));
        const int col0 = u.pn * BM + wc * 32 + 8 * fq; bf16_t* hb = (bf16_t*)(ws + WS_HB); float* ssq = (float*)(ws + WS_SSQ);
        const auto hbrs = __builtin_amdgcn_make_buffer_rsrc((void*)(ws + WS_HB), 0, MT * 1024 * 2, 0x00020000);
        const auto finish = [&](int ai, int m, const f32x4 (&h0)[2], const f32x4 (&h1)[2]) {
            const int row = u.pm * BM + ai * HALF + wr * 64 + m * 16 + fr;
            float ss = 0.f;
#pragma unroll
            for (int bj = 0; bj < 2; ++bj) {
                const size_t off = (size_t)row * 1024 + col0 + bj * HALF;
                const f32x4 o0 = h0[bj] + acc[ai][bj][m][0] * scale, o1 = h1[bj] + acc[ai][bj][m][1] * scale;
                if (fout) { *(f32x4*)(fout + off) = o0; *(f32x4*)(fout + off + 4) = o1; }
                else {
                    u32x4 w; w.x = cvt_pk_bf16(o0[0], o0[1]); w.y = cvt_pk_bf16(o0[2], o0[3]); w.z = cvt_pk_bf16(o1[0], o1[1]); w.w = cvt_pk_bf16(o1[2], o1[3]);
                    __builtin_amdgcn_raw_buffer_store_b128(w, hbrs, (unsigned)off * 2u, 0, 16);
                    ss += (o0[0] * o0[0] + o0[1] * o0[1]) + (o0[2] * o0[2] + o0[3] * o0[3]) + (o1[0] * o1[0] + o1[1] * o1[1]) + (o1[2] * o1[2] + o1[3] * o1[3]);
                }
            }
            if (!fout) { ss += __shfl_xor(ss, 16); ss += __shfl_xor(ss, 32); if (fq == 0) ssq[(size_t)row * 16 + u.pn * 4 + wc] = ss; }
        };
        if (xin) {
#pragma unroll
            for (int ai = 0; ai < 2; ++ai) {
                f32x4 pre[4][2][2];
#pragma unroll
                for (int m = 0; m < 4; ++m)
#pragma unroll
                    for (int bj = 0; bj < 2; ++bj) { const size_t off = (size_t)(u.pm * BM + ai * HALF + wr * 64 + m * 16 + fr) * 1024 + col0 + bj * HALF; pre[m][bj][0] = *(const f32x4*)(xin + off); pre[m][bj][1] = *(const f32x4*)(xin + off + 4); }
#pragma unroll
                for (int m = 0; m < 4; ++m) { const f32x4 h0[2] = {pre[m][0][0], pre[m][1][0]}, h1[2] = {pre[m][0][1], pre[m][1][1]}; finish(ai, m, h0, h1); }
                asm volatile("" ::: "memory");
            }
        } else {
            u32x4 praw[2][4][2];
#pragma unroll
            for (int ai = 0; ai < 2; ++ai)
#pragma unroll
                for (int m = 0; m < 4; ++m)
#pragma unroll
                    for (int bj = 0; bj < 2; ++bj) praw[ai][m][bj] = *(const u32x4*)(hb + (size_t)(u.pm * BM + ai * HALF + wr * 64 + m * 16 + fr) * 1024 + col0 + bj * HALF);
#pragma unroll
            for (int ai = 0; ai < 2; ++ai)
#pragma unroll
                for (int m = 0; m < 4; ++m) {
                    f32x4 h0[2], h1[2];
#pragma unroll
                    for (int bj = 0; bj < 2; ++bj) { const u32x4 w = praw[ai][m][bj];
                        h0[bj] = (f32x4){__builtin_bit_cast(float, w.x << 16), __builtin_bit_cast(float, w.x & 0xffff0000u), __builtin_bit_cast(float, w.y << 16), __builtin_bit_cast(float, w.y & 0xffff0000u)};
                        h1[bj] = (f32x4){__builtin_bit_cast(float, w.z << 16), __builtin_bit_cast(float, w.z & 0xffff0000u), __builtin_bit_cast(float, w.w << 16), __builtin_bit_cast(float, w.w & 0xffff0000u)}; }
                    finish(ai, m, h0, h1);
                    asm volatile("" ::: "memory");
                }
        }
    }
};

constexpr float ATT_C2 = 0.125f * 1.4426950408889634f;
struct EpiInProj {
    static constexpr bool PERM = false, AFTER_DRAIN = false; static constexpr int DUPN = (PROBE_EPI == 3) ? 1 : 0;
    unsigned char* ws; int layer; int hs_off; int tbl;
    __device__ __forceinline__ void operator()(const f32x4 (&acc)[2][2][4][2], const Unit& u, int wr, int wc, int fr, int fq, int ui, PG8_LAS unsigned char* lds) const {
        asm volatile("" : "+v"(fr), "+v"(fq));
        const int dp = ui >> 16; ui &= 0xffff; const bool st_en = !(PROBE_EPI == 3 && ((PROBE_EPIX == 1 && dp == 1) || (PROBE_EPIX == 6 && dp == 0)) && ((const volatile unsigned*)(ws + WS_CTL))[64] == 0u);
        if (PROBE_EPI == 3 && PROBE_EPIX >= 2 && PROBE_EPIX <= 5 && dp == 1) { const int pn_ = u.pn + (hs_off >> 2); const bool sel = PROBE_EPIX == 2 ? pn_ == 11 : (PROBE_EPIX == 3 ? pn_ < 2 : (PROBE_EPIX == 4 ? (pn_ >= 2 && pn_ < 5) : (pn_ >= 5 && pn_ < 11))); if (!sel) return; }
        const int hs = u.pn * 4 + wc + hs_off;
        if (hs >= 51) return;
        const float* ssq = (const float*)(ws + WS_SSQ); const PG8_LAS float* pb = (const PG8_LAS float*)(lds + PBL_OFF);
        if (hs == 44) {
            f32x4 al0, al1, db0, db1;
#pragma unroll
            for (int j = 0; j < 8; ++j) { const int d = 8 * fq + j - 12; const bool v = (d >= 0 && d < 12); const float a_ = v ? -__expf(pb[PB_ALOG + (v ? d : 0)]) : 0.f, b_ = v ? pb[PB_DTB + (v ? d : 0)] : 0.f;
                if (j < 4) { al0[j] = a_; db0[j] = b_; } else { al1[j - 4] = a_; db1[j - 4] = b_; } }
#pragma unroll
            for (int ai = 0; ai < 2; ++ai)
#pragma unroll
                for (int m = 0; m < 4; ++m) {
                    const int row = u.pm * BM + ai * HALF + wr * 64 + m * 16 + fr;
                    const float r = rstd_of(lds, ssq, tbl != 0, ui, ai * HALF + wr * 64 + m * 16 + fr, row, fq);
                    const f32x4 z0 = acc[ai][0][m][0] * r + db0, z1 = acc[ai][0][m][1] * r + db1;
                    f32x4 t0, t1;
#pragma unroll
                    for (int e = 0; e < 4; ++e) { t0[e] = __builtin_amdgcn_exp2f(fabsf(z0[e]) * -1.4426950408889634f); t1[e] = __builtin_amdgcn_exp2f(fabsf(z1[e]) * -1.4426950408889634f); }
                    asm volatile("" : "+v"(t0), "+v"(t1));
                    const f32x4 d0 = t0 + 1.0f, d1 = t1 + 1.0f;
                    f32x4 rc0, rc1, lg0, lg1;
#pragma unroll
                    for (int e = 0; e < 4; ++e) { rc0[e] = __builtin_amdgcn_rcpf(d0[e]); rc1[e] = __builtin_amdgcn_rcpf(d1[e]); }
#pragma unroll
                    for (int e = 0; e < 4; ++e) { lg0[e] = __builtin_amdgcn_logf(d0[e]); lg1[e] = __builtin_amdgcn_logf(d1[e]); }
                    asm volatile("" : "+v"(rc0), "+v"(rc1), "+v"(lg0), "+v"(lg1));
                    f32x4 o0, o1;
#pragma unroll
                    for (int e = 0; e < 4; ++e) {
                        const float sg0 = (z0[e] >= 0.f ? 1.0f : t0[e]) * rc0[e], sg1 = (z1[e] >= 0.f ? 1.0f : t1[e]) * rc1[e];
                        const float sp0 = fmaxf(z0[e], 0.f) + lg0[e] * 0.6931471805599453f, sp1 = fmaxf(z1[e], 0.f) + lg1[e] * 0.6931471805599453f;
                        o0[e] = (8 * fq + e < 12) ? sg0 : al0[e] * sp0; o1[e] = (8 * fq + 4 + e < 12) ? sg1 : al1[e] * sp1;
                    }
                    float* gp = (float*)(ws + WS_GT) + (size_t)row * 32 + 8 * fq;
                    *(f32x4*)gp = o0; *(f32x4*)(gp + 4) = o1;
                    asm volatile("" ::: "memory");
                }
            return;
        }
        bf16_t* dst; int ld; const PG8_LAS float* gain = nullptr; bool rope = false, dosilu = false; float sc = 1.f;
        if (hs < 4)       { dst = (bf16_t*)(ws + WS_QO) + 64 * hs;              ld = 1024; gain = pb + PB_AQN; rope = true; sc = ATT_C2; }
        else if (hs < 6)  { dst = (bf16_t*)(ws + WS_KA) + 64 * (hs - 4);        ld = 128;  gain = pb + PB_AKN; rope = true; }
        else if (hs < 8)  { dst = (bf16_t*)(ws + WS_VA) + 64 * (hs - 6);        ld = 128; }
        else if (hs < 14) { dst = (bf16_t*)(ws + WS_QO) + 256 + 64 * (hs - 8);  ld = 1024; gain = pb + PB_BQN; sc = ATT_C2; }
        else if (hs < 20) { dst = (bf16_t*)(ws + WS_KB) + 64 * (hs - 14);       ld = 384;  gain = pb + PB_BKN; }
        else if (hs < 26) { dst = (bf16_t*)(ws + WS_VB) + 64 * (hs - 20);       ld = 384; }
        else if (hs < 44) { dst = (bf16_t*)(ws + WS_CR) + 64 * (hs - 26);       ld = 1152; }
        else              { dst = (bf16_t*)(ws + WS_CZ) + 64 * (hs - 45);       ld = 384;  dosilu = true; }
        const auto drs = __builtin_amdgcn_make_buffer_rsrc((void*)dst, 0, 0x7fffffff, 0x00020000);
        float g0[8], g1[8];
#pragma unroll
        for (int j = 0; j < 8; ++j) { g0[j] = gain ? gain[8 * fq + j] * sc : sc; g1[j] = gain ? gain[32 + 8 * fq + j] * sc : sc; }
        float inv[8];
#pragma unroll
        for (int j = 0; j < 8; ++j) inv[j] = rope ? __builtin_amdgcn_exp2f(-(float)(8 * (fq & 1) + j) * (13.287712379549449f / 16.0f)) : 0.f;
#pragma unroll
        for (int ai = 0; ai < 2; ++ai) {
            float rs[4];
#pragma unroll
            for (int m = 0; m < 4; ++m) rs[m] = rstd_of(lds, ssq, tbl != 0, ui, ai * HALF + wr * 64 + m * 16 + fr, u.pm * BM + ai * HALF + wr * 64 + m * 16 + fr, fq);
#pragma unroll
            for (int m = 0; m < 4; ++m) {
                const int row = u.pm * BM + ai * HALF + wr * 64 + m * 16 + fr;
                const float r = rs[m];
                float v0[8], v1[8];
#pragma unroll
                for (int j = 0; j < 8; ++j) { v0[j] = acc[ai][0][m][j >> 2][j & 3] * r; v1[j] = acc[ai][1][m][j >> 2][j & 3] * r; }
                float rn = 1.f;
                if (gain) {
                    float ss = 0.f;
#pragma unroll
                    for (int j = 0; j < 8; ++j) ss += v0[j] * v0[j] + v1[j] * v1[j];
                    ss += __shfl_xor(ss, 16); ss += __shfl_xor(ss, 32);
                    rn = __builtin_amdgcn_rsqf(ss * (1.0f / 64.0f) + RMS_EPS);
                }
#pragma unroll
                for (int j = 0; j < 8; ++j) { v0[j] *= rn * g0[j]; v1[j] *= rn * g1[j]; }
                if (rope) {
                    const int t = row & 2047; const float pos = (float)((fq < 2) ? (t >> 6) : (t & 63));
#pragma unroll
                    for (int j = 0; j < 8; ++j) { const float ang = pos * inv[j];
                        const float c = __cosf(ang), s = __sinf(ang); const float x1 = v0[j], x2 = v1[j]; v0[j] = x1 * c - x2 * s; v1[j] = x1 * s + x2 * c; }
                }
                if (dosilu) {
#pragma unroll
                    for (int j = 0; j < 8; ++j) { v0[j] = silu_f(v0[j]); v1[j] = silu_f(v1[j]); }
                }
                const unsigned po = (unsigned)(row * ld + 8 * fq) * 2u;
                u32x4 w; w.x = cvt_pk_bf16(v0[0], v0[1]); w.y = cvt_pk_bf16(v0[2], v0[3]); w.z = cvt_pk_bf16(v0[4], v0[5]); w.w = cvt_pk_bf16(v0[6], v0[7]);
                if (st_en) __builtin_amdgcn_raw_buffer_store_b128(w, drs, po, 0, 16); else asm volatile("" :: "v"(w));
                w.x = cvt_pk_bf16(v1[0], v1[1]); w.y = cvt_pk_bf16(v1[2], v1[3]); w.z = cvt_pk_bf16(v1[4], v1[5]); w.w = cvt_pk_bf16(v1[6], v1[7]);
                if (st_en) __builtin_amdgcn_raw_buffer_store_b128(w, drs, po + 64u, 0, 16); else asm volatile("" :: "v"(w));
                asm volatile("" ::: "memory");
            }
        }
    }
};
template <class Epi, class Sched, bool ALIGN_EPI = false, bool SP2 = false, bool HALFCAP = false>
__device__ __forceinline__ void gemm_phase(PG8_LAS unsigned char* lds, const Gemm g, const Sched& S, const Epi& E, int tid_) {
    asm volatile("" : "+v"(tid_)); const int tid = tid_, wid = __builtin_amdgcn_readfirstlane(tid >> 6), lane = tid & 63, wr = wid >> 2, wc = wid & 3, fr = lane & 15, fq = lane >> 4;
    const int K = g.K, nt = K / BK;
    unsigned voffA[2], voffB[2];
#pragma unroll
    for (int i = 0; i < 2; ++i) { int R, C; stage_rc(tid * 16 + i * 8192, R, C); const int Rb = Epi::PERM ? ((R & ~31) + perm32(R & 31)) : R;
        voffA[i] = (unsigned)(R * K + C) * 2u; voffB[i] = (unsigned)(Rb * K + C) * 2u; }
    const size_t kstep = (size_t)(BK * 2);
    const size_t hstep = (size_t)HALF * K * 2;
    const size_t tstep = 2 * hstep;
    const unsigned ldsw = (unsigned)wid * 1024u;
    int aoff = lds_byte(wr * 64 + fr, fq * 8); const int boff = lds_byte(wc * 32 + fr, fq * 8);
#define PG8_SA(b, h) (((b) * 2 + (h)) * HTB)
#define PG8_SB(b, h) ((4 + (b) * 2 + (h)) * HTB)
#define PG8_STAGE(bufoff, gbase, voff) do { _Pragma("unroll") for (int _i = 0; _i < 2; ++_i) \
        __builtin_amdgcn_global_load_lds((const unsigned*)((const char*)(gbase) + (voff)[_i]), (PG8_LAS unsigned*)(lds + (bufoff) + ldsw + _i * 8192), 16, 0, 0); } while (0)
#define PG8_STAGEA(bufoff, gbase) do { _Pragma("unroll") for (int _i = 0; _i < NPA; ++_i) \
        __builtin_amdgcn_global_load_lds((const unsigned*)((const char*)(gbase) + voffA[_i]), (PG8_LAS unsigned*)(lds + (bufoff) + ldsw + _i * 8192), 16, 0, 0); } while (0)
#define PG8_STAGEA_N(bufoff, gbase, trc) do { _Pragma("unroll") for (int _i = 0; _i < 2; ++_i) if (_i < NPA || (trc)) \
        __builtin_amdgcn_global_load_lds((const unsigned*)((const char*)(gbase) + voffA[_i]), (PG8_LAS unsigned*)(lds + (bufoff) + ldsw + _i * 8192), 16, 0, 0); } while (0)
#define PG8_WAIT_SEL(trc, a, b) do { if (trc) PG8_WAIT_V(a); else PG8_WAIT_V(b); } while (0)
#define PG8_LDA(dst, b, h) do { _Pragma("unroll") for (int m = 0; m < MFR; ++m) _Pragma("unroll") for (int k = 0; k < 2; ++k) dst[m][k] = *(const PG8_LAS bf16x8*)(lds + PG8_SA(b, h) + aoff + m * 2048 + k * 1024); } while (0)
#define PG8_LDB(dst, b, h) do { _Pragma("unroll") for (int n = 0; n < 2; ++n) _Pragma("unroll") for (int k = 0; k < 2; ++k) dst[n][k] = *(const PG8_LAS bf16x8*)(lds + PG8_SB(b, h) + boff + n * 2048 + k * 1024); } while (0)
#define PG8_MMA(ai, bj, At, Bt) do { __builtin_amdgcn_s_setprio(1); _Pragma("unroll") for (int m = 0; m < MFR; ++m) _Pragma("unroll") for (int n = 0; n < 2; ++n) _Pragma("unroll") for (int k = 0; k < 2; ++k) \
        acc[ai][bj][m][n] = __builtin_amdgcn_mfma_f32_16x16x32_bf16(Bt[n][k], At[m][k], acc[ai][bj][m][n], 0, 0, 0); __builtin_amdgcn_s_setprio(0); } while (0)
#define PG8_WAIT_V(n) asm volatile("s_waitcnt vmcnt(" #n ")" ::: "memory")
#define PG8_WAIT_L(n) asm volatile("s_waitcnt lgkmcnt(" #n ")" ::: "memory")
#define PG8_BAR __builtin_amdgcn_s_barrier()
#define PG8_SCHED __builtin_amdgcn_sched_barrier(0)
    Unit cur, nxt; int ui = 0;
    if (!S.next(0, cur)) return;
    static_assert(!HALFCAP || SP2, "half units: SP2 loop only");
    f32x4 acc[2][2][4][2];
#pragma unroll
    for (int a = 0; a < 2; ++a)
#pragma unroll
        for (int b = 0; b < 2; ++b)
#pragma unroll
            for (int m = 0; m < 4; ++m)
#pragma unroll
                for (int n = 0; n < 2; ++n) acc[a][b][m][n] = (f32x4){0.f, 0.f, 0.f, 0.f};
    bf16x8 At[4][2], B0[2][2], B1[2][2];
    const char* cA = (const char*)g.A + (size_t)cur.pm * tstep; const char* cB = (const char*)g.Bt + (size_t)cur.pn * tstep;
    size_t ahs = hstep;
    if constexpr (HALFCAP) { if (cur.hm) { if (cur.hm == 2) cA += hstep; ahs = hstep >> 1; aoff = lds_byte(wr * 32 + fr, fq * 8); } }
    S.a_ready(cur);
    {   constexpr int NPA = 2;
    if constexpr (SP2) {
        PG8_STAGE(PG8_SB(0, 0), cB, voffB); PG8_STAGE(PG8_SB(0, 1), cB + hstep, voffB); PG8_STAGEA(PG8_SA(0, 0), cA); PG8_STAGEA(PG8_SA(0, 1), cA + ahs);
        if (wr == 1) PG8_BAR;
        PG8_WAIT_V(2); PG8_BAR;
        PG8_STAGE(PG8_SB(1, 0), cB + kstep, voffB); PG8_STAGEA(PG8_SA(1, 0), cA + kstep); PG8_STAGE(PG8_SB(1, 1), cB + hstep + kstep, voffB);
        PG8_WAIT_V(6); PG8_BAR;
    } else {
        PG8_STAGE(PG8_SB(0, 0), cB, voffB); PG8_STAGE(PG8_SA(0, 0), cA, voffA); PG8_STAGE(PG8_SB(0, 1), cB + hstep, voffB); PG8_STAGE(PG8_SA(0, 1), cA + hstep, voffA);
        if (wr == 1) PG8_BAR;
        PG8_WAIT_V(4); PG8_BAR;
        PG8_STAGE(PG8_SB(1, 0), cB + kstep, voffB); PG8_STAGE(PG8_SA(1, 0), cA + kstep, voffA); PG8_STAGE(PG8_SB(1, 1), cB + hstep + kstep, voffB);
        PG8_WAIT_V(6); PG8_BAR;
    }
    }
#define PG8_KLOOP(WV, TRX) \
        for (int t = 0; t < nt; t += 2) { \
            const bool last = (t == nt - 2); \
            const bool trc = last && (TRX);            \
            const char* a1 = cA + (size_t)(t + 1) * kstep; \
            const char* a2 = last ? nA : cA + (size_t)(t + 2) * kstep; const char* b2 = last ? nB : cB + (size_t)(t + 2) * kstep; \
            const char* a3 = a2 + kstep; const char* b3 = b2 + kstep; \
            const size_t ah2 = last ? nahs : ahs; \
            if (last && has_next) S.a_ready(nxt); \
            PG8_LDB(B0, 0, 0); PG8_LDB(B1, 0, 1); PG8_SCHED; PG8_LDA(At, 0, 0); PG8_STAGEA(PG8_SA(1, 1), a1 + ahs); \
            PG8_WAIT_V(WV); PG8_WAIT_L(0); PG8_BAR; PG8_MMA(0, 0, At, B0); PG8_MMA(0, 1, At, B1); PG8_BAR; PG8_SCHED; \
            PG8_LDA(At, 0, 1); PG8_STAGE(PG8_SB(0, 0), b2, voffB); PG8_STAGE(PG8_SB(0, 1), b2 + hstep, voffB); PG8_STAGEA_N(PG8_SA(0, 0), a2, trc); \
            PG8_WAIT_SEL(trc, 7, WV); PG8_WAIT_L(0); PG8_BAR; PG8_MMA(1, 0, At, B0); PG8_MMA(1, 1, At, B1); PG8_BAR; PG8_SCHED; \
            PG8_LDB(B0, 1, 0); PG8_LDB(B1, 1, 1); PG8_SCHED; PG8_LDA(At, 1, 0); PG8_STAGEA_N(PG8_SA(0, 1), a2 + ah2, trc); \
            PG8_WAIT_SEL(trc, 8, WV); PG8_WAIT_L(0); PG8_BAR; PG8_MMA(0, 0, At, B0); PG8_MMA(0, 1, At, B1); PG8_BAR; PG8_SCHED; \
            PG8_LDA(At, 1, 1); PG8_STAGE(PG8_SB(1, 0), b3, voffB); PG8_STAGE(PG8_SB(1, 1), b3 + hstep, voffB); PG8_STAGEA_N(PG8_SA(1, 0), a3, trc); \
            PG8_WAIT_SEL(trc, 8, WV); PG8_WAIT_L(0); PG8_BAR; PG8_MMA(1, 0, At, B0); PG8_MMA(1, 1, At, B1); PG8_BAR; PG8_SCHED; \
        }
    for (;;) {
        const bool has_next = S.next(ui + 1, nxt);
        const char* nA = has_next ? (const char*)g.A + (size_t)nxt.pm * tstep : cA; const char* nB = has_next ? (const char*)g.Bt + (size_t)nxt.pn * tstep : cB;
        size_t nahs = has_next ? hstep : ahs;
        if constexpr (HALFCAP) { if (has_next && nxt.hm) { if (nxt.hm == 2) nA += hstep; nahs = hstep >> 1; } }
        if constexpr (SP2) {
            if constexpr (HALFCAP) {
                if (cur.hm) { constexpr int MFR = 2, NPA = 1; const bool nfull = has_next && !nxt.hm; PG8_KLOOP(6, nfull) }
                else { constexpr int MFR = 4, NPA = 2; PG8_KLOOP(8, false) }
            } else { constexpr int MFR = 4, NPA = 2; PG8_KLOOP(8, false) }
        } else {
        constexpr int MFR = 4;
        for (int t = 0; t < nt; t += 2) {
            const bool last = (t == nt - 2);
            const char* a1 = cA + (size_t)(t + 1) * kstep;
            const char* a2 = last ? nA : cA + (size_t)(t + 2) * kstep; const char* b2 = last ? nB : cB + (size_t)(t + 2) * kstep;
            const char* a3 = a2 + kstep; const char* b3 = b2 + kstep;
            if (last && has_next) S.a_ready(nxt);
            PG8_LDB(B0, 0, 0); PG8_SCHED; PG8_LDA(At, 0, 0); PG8_STAGE(PG8_SA(1, 1), a1 + hstep, voffA);
            PG8_WAIT_L(8); PG8_BAR; PG8_WAIT_L(0); PG8_MMA(0, 0, At, B0); PG8_BAR; PG8_SCHED;
            PG8_LDB(B1, 0, 1); PG8_STAGE(PG8_SB(0, 0), b2, voffB);
            PG8_BAR; PG8_WAIT_L(0); PG8_MMA(0, 1, At, B1); PG8_BAR;
            PG8_LDA(At, 0, 1); PG8_STAGE(PG8_SA(0, 0), a2, voffA);
            PG8_BAR; PG8_WAIT_L(0); PG8_MMA(1, 0, At, B0); PG8_BAR; PG8_SCHED;
            PG8_STAGE(PG8_SB(0, 1), b2 + hstep, voffB);
            PG8_WAIT_V(6); PG8_BAR; PG8_MMA(1, 1, At, B1); PG8_BAR;
            PG8_LDB(B0, 1, 0); PG8_SCHED; PG8_LDA(At, 1, 0); PG8_STAGE(PG8_SA(0, 1), a2 + hstep, voffA);
            PG8_WAIT_L(8); PG8_BAR; PG8_WAIT_L(0); PG8_MMA(0, 0, At, B0); PG8_BAR; PG8_SCHED;
            PG8_LDB(B1, 1, 1); PG8_STAGE(PG8_SB(1, 0), b3, voffB);
            PG8_BAR; PG8_WAIT_L(0); PG8_MMA(0, 1, At, B1); PG8_BAR;
            PG8_LDA(At, 1, 1); PG8_STAGE(PG8_SA(1, 0), a3, voffA);
            PG8_BAR; PG8_WAIT_L(0); PG8_MMA(1, 0, At, B0); PG8_BAR; PG8_SCHED;
            PG8_STAGE(PG8_SB(1, 1), b3 + hstep, voffB);
            PG8_WAIT_V(6); PG8_BAR; PG8_MMA(1, 1, At, B1); PG8_BAR;
        }
        }
        if constexpr (ALIGN_EPI) { if (wr == 0) PG8_BAR; }
        if constexpr (!Epi::AFTER_DRAIN) { _Pragma("unroll 1") for (int dp_ = 0; dp_ <= Epi::DUPN; ++dp_) { const int le_ = pg8_lane_id(); E(acc, cur, wr, wc, le_ & 15, le_ >> 4, ui | (dp_ << 16), lds); } S.done(cur); }
        if (!has_next) break;
#pragma unroll
        for (int a = 0; a < 2; ++a)
#pragma unroll
            for (int b = 0; b < 2; ++b)
#pragma unroll
                for (int m = 0; m < 4; ++m)
#pragma unroll
                    for (int n = 0; n < 2; ++n) acc[a][b][m][n] = (f32x4){0.f, 0.f, 0.f, 0.f};
        cur = nxt; cA = nA; cB = nB; ahs = nahs; ++ui;
        if constexpr (HALFCAP) { const int le_ = pg8_lane_id(); aoff = lds_byte((cur.hm ? wr * 32 : wr * 64) + (le_ & 15), (le_ >> 4) * 8); }
        if constexpr (ALIGN_EPI) { if (wr == 1) PG8_BAR; }
    }
    PG8_WAIT_V(0);
    if constexpr (!ALIGN_EPI) { if (wr == 0) PG8_BAR; }
    PG8_BAR;
    if constexpr (Epi::AFTER_DRAIN) { E.fused(acc, cur, wr, wc, fr, fq, lds, wid, lane); S.done(cur); }
#undef PG8_SA
#undef PG8_SB
#undef PG8_STAGE
#undef PG8_LDA
#undef PG8_STAGEA
#undef PG8_STAGEA_N
#undef PG8_WAIT_SEL
#undef PG8_KLOOP
#undef PG8_LDB
#undef PG8_MMA
#undef PG8_WAIT_V
#undef PG8_WAIT_L
#undef PG8_BAR
#undef PG8_SCHED
}
}

__device__ __forceinline__ unsigned f2bf(float f) { unsigned u = __builtin_bit_cast(unsigned, f); return (u + 0x7fffu + ((u >> 16) & 1u)) >> 16; }
__device__ __forceinline__ unsigned pk2(float lo, float hi) { return f2bf(lo) | (f2bf(hi) << 16); }
__device__ __forceinline__ float bf2f(bf16 b) { return __builtin_bit_cast(float, (unsigned)b << 16); }
__device__ __forceinline__ float wave_sum(float v) {
#pragma unroll
    for (int o = 1; o < 64; o <<= 1) v += __shfl_xor(v, o);
    return v;
}

__device__ __forceinline__ int t5_bucket_dev(int rel) {
    const int n = rel < 0 ? -rel : rel; const int sign = rel > 0 ? 16 : 0;
    const float nf = (float)(n > 1 ? n : 1);
    int large = 8 + (int)(logf(nf / 8.0f) / 4.852030263919617f * 8.0f);
    large = large < 15 ? large : 15;
    return sign + (n < 8 ? n : large);
}

struct MKArgs { const float* in[21]; float* out; unsigned char* ws; int ph_lo, ph_hi; };
typedef MKArgs ProArgs;
__device__ __forceinline__ void cvt_item(const float* W, int ldw, int c0, int nvalid, const float* gain, bf16* dst0, int K, int k0, LAS float* scr, int lane) {
    if (nvalid == 32) {
        const int kr = lane >> 3, c4 = (lane & 7) * 4;
        f32x4 v[8];
#pragma unroll
        for (int i = 0; i < 8; ++i) v[i] = *(const f32x4*)(W + (size_t)(k0 + 8 * i + kr) * ldw + c0 + c4);
#pragma unroll
        for (int i = 0; i < 8; ++i) { const int kk = 8 * i + kr; const float gsc = gain ? gain[k0 + kk] : 1.0f;
            scr[kk * 33 + c4] = v[i][0] * gsc; scr[kk * 33 + c4 + 1] = v[i][1] * gsc; scr[kk * 33 + c4 + 2] = v[i][2] * gsc; scr[kk * 33 + c4 + 3] = v[i][3] * gsc; }
    } else {
#pragma unroll 8
        for (int i = 0; i < 32; ++i) { const int kk = 2 * i + (lane >> 5), j = lane & 31;
            float v = (j < nvalid) ? W[(size_t)(k0 + kk) * ldw + c0 + j] : 0.f; if (gain) v *= gain[k0 + kk];
            scr[kk * 33 + j] = v; }
    }
    asm volatile("s_waitcnt lgkmcnt(0)" ::: "memory");
    const int c = lane & 7;
#pragma unroll
    for (int jj = 0; jj < 4; ++jj) { const int n = (lane >> 3) + 8 * jj; const LAS float* s = scr + (8 * c) * 33 + pg8::perm32(n);
        v4u o; o.x = pk2(s[0 * 33], s[1 * 33]); o.y = pk2(s[2 * 33], s[3 * 33]); o.z = pk2(s[4 * 33], s[5 * 33]); o.w = pk2(s[6 * 33], s[7 * 33]);
        *(v4u*)(dst0 + (size_t)n * K + k0 + 8 * c) = o; }
    asm volatile("s_waitcnt lgkmcnt(0)" ::: "memory");
}
constexpr int IT_GU = (NGU / 32) * (DM / 64), IT_D = (DM / 32) * (DFF / 64), IT_IN = (NINP / 32) * (DM / 64), IT_O = (DM / 32) * (DM / 64);
constexpr int IT_LAYER = 2 * IT_GU + 2 * IT_D + IT_IN + IT_O;
typedef const float* cfp;
#define CAS __attribute__((address_space(4)))
struct CvtD { const float* W; const float* gain; bf16* dst0; int ldw, c0, nvalid, K, k0; };
__device__ __forceinline__ CvtD cvt_decode(const CAS cfp* inp, unsigned char* ws, int it) {
    CvtD d;
    const int l = it / IT_LAYER; int r = it % IT_LAYER;
    unsigned char* wl = ws + WS_W + (size_t)l * W_LAYER;
    if (r < 2 * IT_GU) {
        const int f = r / IT_GU; r %= IT_GU;
        const float* Wg = inp[f ? 18 : 3] + (size_t)l * DM * DFF; const float* Wu = inp[f ? 19 : 4] + (size_t)l * DM * DFF;
        const int ng = NGU / 32, kb = r / ng, g = r % ng, pn = g >> 3, bj = (g >> 2) & 1, wc = g & 3;
        d.W = bj ? Wu : Wg; d.ldw = DFF; d.c0 = 128 * pn + 32 * wc; d.nvalid = 32; d.gain = inp[f ? 17 : 2] + (size_t)l * DM; d.dst0 = (bf16*)(wl + (f ? OFF_GU2 : OFF_GU1)) + (size_t)(32 * g) * DM; d.K = DM; d.k0 = 64 * kb;
        return d;
    }
    r -= 2 * IT_GU;
    if (r < 2 * IT_D) {
        const int f = r / IT_D; r %= IT_D;
        const int ng = DM / 32, kb = r / ng, g = r % ng;
        d.W = inp[f ? 20 : 5] + (size_t)l * DFF * DM; d.ldw = DM; d.c0 = 32 * g; d.nvalid = 32; d.gain = nullptr; d.dst0 = (bf16*)(wl + (f ? OFF_D2 : OFF_D1)) + (size_t)(32 * g) * DFF; d.K = DFF; d.k0 = 64 * kb;
        return d;
    }
    r -= 2 * IT_D;
    if (r < IT_IN) {
        const int ng = NINP / 32, kb = r / ng, g = r % ng, pn = g >> 3, bj = (g >> 2) & 1, wc = g & 3, v = 4 * pn + wc;
        const int c0 = (v < 44 ? 64 * v : (v == 44 ? 3200 : (v < 51 ? 2816 + 64 * (v - 45) : NIN))) + 32 * bj;
        int nv = (v == 44 ? 3224 : (v < 51 ? 1 << 30 : 0)) - c0; nv = nv < 0 ? 0 : (nv > 32 ? 32 : nv);
        d.W = inp[7] + (size_t)l * DM * NIN; d.ldw = NIN; d.c0 = nv > 0 ? c0 : 0; d.nvalid = nv; d.gain = inp[6] + (size_t)l * DM; d.dst0 = (bf16*)(wl + OFF_IN) + (size_t)(32 * g) * DM; d.K = DM; d.k0 = 64 * kb;
        return d;
    }
    r -= IT_IN;
    {   const int ng = DM / 32, kb = r / ng, g = r % ng;
        d.W = inp[16] + (size_t)l * DM * DM; d.ldw = DM; d.c0 = 32 * g; d.nvalid = 32; d.gain = nullptr; d.dst0 = (bf16*)(wl + OFF_O) + (size_t)(32 * g) * DM; d.K = DM; d.k0 = 64 * kb; }
    return d;
}
__device__ __forceinline__ void cvt_out(const CvtD& d, LAS float* scr, int lane) {
    const int c = lane & 7;
#pragma unroll
    for (int jj = 0; jj < 4; ++jj) { const int n = (lane >> 3) + 8 * jj; const LAS float* s = scr + (8 * c) * 33 + pg8::perm32(n);
        v4u o; o.x = pk2(s[0 * 33], s[1 * 33]); o.y = pk2(s[2 * 33], s[3 * 33]); o.z = pk2(s[4 * 33], s[5 * 33]); o.w = pk2(s[6 * 33], s[7 * 33]);
        *(v4u*)(d.dst0 + (size_t)n * d.K + d.k0 + 8 * c) = o; }
}
__device__ __forceinline__ void cvt_pair(const CvtD& a, const CvtD& b, LAS float* scr, int lane) {
    const int kr = lane >> 3, c4 = (lane & 7) * 4; LAS float* sb = scr + 64 * 33;
    f32x4 va[8], vb[8];
#pragma unroll
    for (int i = 0; i < 8; ++i) va[i] = *(const f32x4*)(a.W + (size_t)(a.k0 + 8 * i + kr) * a.ldw + a.c0 + c4);
#pragma unroll
    for (int i = 0; i < 8; ++i) vb[i] = *(const f32x4*)(b.W + (size_t)(b.k0 + 8 * i + kr) * b.ldw + b.c0 + c4);
#pragma unroll
    for (int i = 0; i < 8; ++i) { const int kk = 8 * i + kr; const float ga = a.gain ? a.gain[a.k0 + kk] : 1.0f, gb = b.gain ? b.gain[b.k0 + kk] : 1.0f;
        scr[kk * 33 + c4] = va[i][0] * ga; scr[kk * 33 + c4 + 1] = va[i][1] * ga; scr[kk * 33 + c4 + 2] = va[i][2] * ga; scr[kk * 33 + c4 + 3] = va[i][3] * ga;
        sb[kk * 33 + c4] = vb[i][0] * gb; sb[kk * 33 + c4 + 1] = vb[i][1] * gb; sb[kk * 33 + c4 + 2] = vb[i][2] * gb; sb[kk * 33 + c4 + 3] = vb[i][3] * gb; }
    asm volatile("s_waitcnt lgkmcnt(0)" ::: "memory");
    cvt_out(a, scr, lane); cvt_out(b, sb, lane);
    asm volatile("s_waitcnt lgkmcnt(0)" ::: "memory");
}
constexpr int CVT_WAVE_LDS = 2 * 64 * 33 * 4;
__device__ __forceinline__ void convert_weights(const CAS cfp* inp, unsigned char* ws, LAS unsigned char* lds, int gw, int NGW, int wave, int lane, int part) {
    LAS float* scr = (LAS float*)(lds + wave * CVT_WAVE_LDS);
    bool have = false; CvtD pend;
#pragma unroll 1
    for (int it = gw; it < DEPTH * IT_LAYER; it += NGW) {
        const int l = it / IT_LAYER, r = it % IT_LAYER;
        const bool early = (l == 0) && (r < IT_GU || (r >= 2 * IT_GU && r < 2 * IT_GU + IT_D) || (r >= 2 * IT_GU + 2 * IT_D && r < 2 * IT_GU + 2 * IT_D + IT_IN));
        if (early != (part == 0)) continue;
        const CvtD d = cvt_decode(inp, ws, it);
        if (d.nvalid != 32) { cvt_item(d.W, d.ldw, d.c0, d.nvalid, d.gain, d.dst0, d.K, d.k0, scr, lane); continue; }
        if (have) { cvt_pair(pend, d, scr, lane); have = false; } else { pend = d; have = true; }
    }
    if (have) cvt_item(pend.W, pend.ldw, pend.c0, pend.nvalid, pend.gain, pend.dst0, pend.K, pend.k0, scr, lane);
}
__device__ __forceinline__ void prologue_phase(const CAS cfp* inp, unsigned char* ws, LAS unsigned char* lds, int gw, int NGW, int wave, int lane) {
    convert_weights(inp, ws, lds, gw, NGW, wave, lane, 0);
    {
        float* pb = (float*)(ws + WS_PB);
        for (int i = gw * 64 + lane; i < PB_FLOATS; i += NGW * 64) {
            float v = 0.f;
            if (i >= PB_TB) { const int k = i - PB_TB, hb = k / 136, idx = k % 136, h = hb / 3, br = hb % 3, dil = br == 0 ? 1 : (br == 1 ? 4 : 16);
                v = idx <= 128 ? inp[1][t5_bucket_dev((idx - 64) * dil) * 6 + h] * 1.4426950408889634f : 0.f; }
            else if (i >= PB_REL) v = inp[1][i - PB_REL];
            else { const int l = i / PB_LAYER, r = i % PB_LAYER;
                if (r < 64) v = inp[8][l * 64 + r]; else if (r < 128) v = inp[9][l * 64 + r - 64]; else if (r < 192) v = inp[10][l * 64 + r - 128]; else if (r < 256) v = inp[11][l * 64 + r - 192];
                else if (r < 320) v = inp[15][l * 64 + r - 256]; else if (r < 332) v = inp[13][l * 12 + r - 320]; else if (r < 344) v = inp[14][l * 12 + r - 332];
                else if (r == PB_REFA || r == PB_REFB) {
                    const float* gq = inp[r == PB_REFA ? 8 : 10] + l * 64; const float* gk = inp[r == PB_REFA ? 9 : 11] + l * 64; float mq = 0.f, mk = 0.f, mb = 0.f;
                    for (int e = 0; e < 64; ++e) { mq = fmaxf(mq, fabsf(gq[e])); mk = fmaxf(mk, fabsf(gk[e])); }
                    if (r == PB_REFB) for (int e = 0; e < 192; ++e) mb = fmaxf(mb, inp[1][e] * 1.4426950408889634f);
                    v = 0.125f * 1.4426950408889634f * 64.0f * mq * mk + mb; }
                else if (r >= PB_CONV) v = inp[12][(size_t)l * 5760 + r - PB_CONV]; }
            pb[i] = v; }
    }
    const float* x = inp[0]; bf16* hb = (bf16*)(ws + WS_HB); float* ssq = (float*)(ws + WS_SSQ);
#pragma unroll 1
    for (int m0 = gw; m0 < MT; m0 += 4 * NGW) {
        f32x4 v[4][4];
#pragma unroll
        for (int r = 0; r < 4; ++r) { const int m = m0 + r * NGW; const f32x4* xr = (const f32x4*)(x + (size_t)(m < MT ? m : gw) * DM) + lane;
#pragma unroll
            for (int j = 0; j < 4; ++j) v[r][j] = xr[64 * j]; }
#pragma unroll
        for (int r = 0; r < 4; ++r) { const int m = m0 + r * NGW; if (m >= MT) break;
            unsigned long long* o8 = (unsigned long long*)(hb + (size_t)m * DM) + lane;
#pragma unroll
            for (int j = 0; j < 4; ++j) { const f32x4 w = v[r][j];
                o8[64 * j] = (unsigned long long)pk2(w[0], w[1]) | ((unsigned long long)pk2(w[2], w[3]) << 32);
                float s = (w[0] * w[0] + w[1] * w[1]) + (w[2] * w[2] + w[3] * w[3]);
                s += __shfl_xor(s, 1); s += __shfl_xor(s, 2); s += __shfl_xor(s, 4); s += __shfl_xor(s, 8);
                if ((lane & 15) == 0) ssq[(size_t)m * 16 + 4 * j + (lane >> 4)] = s; }
        }
    }
}
namespace att {
typedef short bf16x8 __attribute__((ext_vector_type(8)));
typedef short v4i16 __attribute__((ext_vector_type(4)));
typedef float f32x16 __attribute__((ext_vector_type(16)));
typedef float f32x2_t __attribute__((ext_vector_type(2)));
typedef __bf16 bf16x2_t __attribute__((ext_vector_type(2)));
constexpr int NS = 4, DP = 3;
constexpr int L_K = 0, L_V = NS * 8192, L_WS = 2 * NS * 8192, L_TB = L_WS + 2048, L_OST = L_TB + 18 * 544, L_END = L_OST + 8 * 4096;
__device__ __forceinline__ void ring_wait(int rem) {
    if (rem >= 2) asm volatile("s_waitcnt vmcnt(4)" ::: "memory"); else if (rem == 1) asm volatile("s_waitcnt vmcnt(2)" ::: "memory"); else asm volatile("s_waitcnt vmcnt(0)" ::: "memory");
    __builtin_amdgcn_s_barrier(); asm volatile("" ::: "memory");
}
__device__ __forceinline__ int crow(int r, int hi) { return (r & 3) + 8 * (r >> 2) + 4 * hi; }
__device__ __forceinline__ unsigned cvtpk(float lo, float hi) { f32x2_t v = {lo, hi}; bf16x2_t b = __builtin_convertvector(v, bf16x2_t); return __builtin_bit_cast(unsigned, b); }
__device__ __forceinline__ v4i16 vtr(const LAS char* p) { return __builtin_amdgcn_ds_read_tr16_b64_v4i16((LAS v4i16*)p); }
__device__ __forceinline__ void stage16(const void* gsrc, LAS unsigned char* dst_wave_uniform) { unsigned keep; const unsigned d = (unsigned)__builtin_amdgcn_readfirstlane((int)(unsigned)(uintptr_t)dst_wave_uniform);
    asm volatile("s_mov_b32 %0, m0\n\ts_mov_b32 m0, %2\n\ts_nop 0\n\tglobal_load_lds_dwordx4 %1, off\n\ts_mov_b32 m0, %0" : "=&s"(keep) : "v"(gsrc), "s"(d) : "memory"); }

template <int MODE>
__device__ __forceinline__ void tile_compute(const LAS char* Kb, const LAS char* Vb, const bf16x8 (&qf)[4], f32x16 (&o)[2], float& lsum, float negref, int r32, int hi, int lane,
                                             int ik0, int iq, int L, const LAS float* tb) {
    f32x16 p0, p1;
#pragma unroll
    for (int r = 0; r < 16; ++r) { p0[r] = negref; p1[r] = negref; }
    const LAS char* kp = Kb + hi * 1024 + r32 * 16;
    bf16x8 kf0[4], kf1[4];
#pragma unroll
    for (int s = 0; s < 4; ++s) { kf0[s] = *(const LAS bf16x8*)(kp + s * 2048); kf1[s] = *(const LAS bf16x8*)(kp + s * 2048 + 512); }
    __builtin_amdgcn_s_setprio(1);
#pragma unroll
    for (int s = 0; s < 4; ++s) {
        p0 = __builtin_amdgcn_mfma_f32_32x32x16_bf16(kf0[s], qf[s], p0, 0, 0, 0);
        p1 = __builtin_amdgcn_mfma_f32_32x32x16_bf16(kf1[s], qf[s], p1, 0, 0, 0);
    }
    __builtin_amdgcn_s_setprio(0);
    if (MODE == 1) {
        const int d0 = ik0 - iq + 64;
        {   float bb[16];
#pragma unroll
            for (int r = 0; r < 16; ++r) bb[r] = tb[min(max(d0 + crow(r, hi), 0), 128)];
#pragma unroll
            for (int r = 0; r < 16; ++r) { const int x0 = d0 + crow(r, hi); p0[r] = __builtin_amdgcn_exp2f(p0[r] + (((unsigned)x0 <= 128u) ? bb[r] : -1e30f)); }
        }
        {   float bb[16];
#pragma unroll
            for (int r = 0; r < 16; ++r) bb[r] = tb[min(max(d0 + 32 + crow(r, hi), 0), 128)];
#pragma unroll
            for (int r = 0; r < 16; ++r) { const int x1 = d0 + 32 + crow(r, hi); p1[r] = __builtin_amdgcn_exp2f(p1[r] + (((unsigned)x1 <= 128u) ? bb[r] : -1e30f)); }
        }
    } else {
#pragma unroll
        for (int r = 0; r < 16; ++r) { p0[r] = __builtin_amdgcn_exp2f(p0[r]); p1[r] = __builtin_amdgcn_exp2f(p1[r]); }
    }
    float sa = 0.f, sb = 0.f;
#pragma unroll
    for (int r = 0; r < 16; ++r) { sa += p0[r]; sb += p1[r]; }
    lsum += sa + sb;
    bf16x8 pa[4];
#pragma unroll
    for (int ks = 0; ks < 4; ++ks) {
        unsigned w[4];
#pragma unroll
        for (int e = 0; e < 4; ++e) { const int r = 8 * (ks & 1) + 2 * e; w[e] = (ks < 2) ? cvtpk(p0[r], p0[r + 1]) : cvtpk(p1[r], p1[r + 1]); }
        typedef unsigned u32x4_t __attribute__((ext_vector_type(4)));
        const u32x4_t wv = {w[0], w[1], w[2], w[3]};
        pa[ks] = __builtin_bit_cast(bf16x8, wv);
    }
    const LAS char* vp = Vb + ((lane >> 4) & 1) * 32 + (lane & 3) * 8 + (4 * hi + ((lane & 15) >> 2)) * 64;
#pragma unroll
    for (int dh = 0; dh < 2; ++dh) {
        bf16x8 vf[4];
#pragma unroll
        for (int ks = 0; ks < 4; ++ks) { const v4i16 lo = vtr(vp + dh * 4096 + ks * 1024), hh = vtr(vp + dh * 4096 + ks * 1024 + 512); vf[ks] = (bf16x8){lo[0], lo[1], lo[2], lo[3], hh[0], hh[1], hh[2], hh[3]}; }
        __builtin_amdgcn_s_setprio(1);
#pragma unroll
        for (int ks = 0; ks < 4; ++ks) o[dh] = __builtin_amdgcn_mfma_f32_32x32x16_bf16(pa[ks], vf[ks], o[dh], 0, 0, 0);
        __builtin_amdgcn_s_setprio(0);
    }
}

template <class RowPtr> __device__ __forceinline__ void store_tile(LAS unsigned char* stg, const f32x16 (&o)[2], const float (&sc)[16], int r32, int hi, int lane, RowPtr rowptr) {
#pragma unroll
    for (int r = 0; r < 16; ++r) { const int q = crow(r, hi);
        *(LAS unsigned short*)(stg + q * 128 + r32 * 2) = (unsigned short)cvtpk(o[0][r] * sc[r], 0.f); *(LAS unsigned short*)(stg + q * 128 + 64 + r32 * 2) = (unsigned short)cvtpk(o[1][r] * sc[r], 0.f); }
    asm volatile("s_waitcnt lgkmcnt(0)" ::: "memory");
    typedef unsigned u32x4_t __attribute__((ext_vector_type(4)));
#pragma unroll
    for (int i = 0; i < 4; ++i) { const int row = i * 8 + (lane >> 3), ch = lane & 7; const u32x4_t v = *(const LAS u32x4_t*)(stg + row * 128 + ch * 16); *(u32x4_t*)(rowptr(row) + ch * 8) = v; }
}

__device__ __forceinline__ void itemA(LAS unsigned char* lds, int item, int tid, unsigned char* ws, float refA, bf16* Obase, int opitch) {
    const int lane = tid & 63, wave = __builtin_amdgcn_readfirstlane(tid >> 6), r32 = lane & 31, hi = lane >> 5;
    const int qb = item & 7, h = (item >> 3) & 3, b = item >> 5, kvh = h >> 1;
    bf16* QO = (bf16*)(ws + WS_QO); const bf16* KA = (const bf16*)(ws + WS_KA); const bf16* VA = (const bf16*)(ws + WS_VA);
    const size_t rowbase = (size_t)b * SEQ;
    const bf16* ksrc = KA + (rowbase + lane) * 128 + kvh * 64 + wave * 8;
    const bf16* vsrc = VA + (rowbase + 16 * (wave & 3) + (lane >> 2)) * 128 + kvh * 64 + (wave >> 2) * 32 + (lane & 3) * 8;
    LAS unsigned char* kdst = lds + L_K + wave * 1024; LAS unsigned char* vdst = lds + L_V + wave * 1024;
#pragma unroll
    for (int t = 0; t < DP; ++t) { stage16(ksrc + (size_t)t * 64 * 128, kdst + t * 8192); stage16(vsrc + (size_t)t * 64 * 128, vdst + t * 8192); }
    bf16* qrow = QO + (rowbase + qb * 256 + wave * 32 + r32) * 1024 + h * 64;
    bf16x8 qf[4];
#pragma unroll
    for (int s = 0; s < 4; ++s) qf[s] = *(const bf16x8*)(qrow + 16 * s + 8 * hi);
    asm volatile("" : "+v"(qf[0]), "+v"(qf[1]), "+v"(qf[2]), "+v"(qf[3]));
    f32x16 o[2];
#pragma unroll
    for (int r = 0; r < 16; ++r) { o[0][r] = 0.f; o[1][r] = 0.f; }
    float lsum = 0.f; const float negref = -refA;
    constexpr int NT = SEQ / 64;
#pragma unroll 1
    for (int t = 0; t < NT; ++t) {
        ring_wait(NT - 1 - t);
        const int cur = t & (NS - 1), nxt = (t + DP) & (NS - 1);
        if (t + DP < NT) { stage16(ksrc + (size_t)(t + DP) * 64 * 128, kdst + nxt * 8192); stage16(vsrc + (size_t)(t + DP) * 64 * 128, vdst + nxt * 8192); }
        tile_compute<0>((const LAS char*)(lds + L_K + cur * 8192), (const LAS char*)(lds + L_V + cur * 8192), qf, o, lsum, negref, r32, hi, lane, 0, 0, 0, nullptr);
    }
    lsum += __shfl_xor(lsum, 32);
    LAS float* wsf = (LAS float*)(lds + L_WS) + wave * 64;
    if (hi == 0) wsf[r32] = lsum;
    asm volatile("s_waitcnt lgkmcnt(0)" ::: "memory");
    float rl[16];
#pragma unroll
    for (int r = 0; r < 16; ++r) rl[r] = __builtin_amdgcn_rcpf(wsf[crow(r, hi)]);
    { bf16* ob = Obase + (rowbase + qb * 256 + wave * 32) * opitch + h * 64; const int op_ = opitch;
      store_tile(lds + L_OST + wave * 4096, o, rl, r32, hi, lane, [=](int row) { return ob + (size_t)row * op_; }); }
    __syncthreads();
}

__device__ __forceinline__ void fill_tables(LAS unsigned char* lds, const float* tbg, int tid) {
    for (int i = tid; i < 18 * 136; i += 512) ((LAS float*)(lds + L_TB))[i] = tbg[i];
    __syncthreads();
}
__device__ __forceinline__ void itemB(LAS unsigned char* lds, int item, int tid, unsigned char* ws, float refB, bf16* const (&Pb)[3], float* const (&Lb)[3]) {
    const int lane = tid & 63, wave = __builtin_amdgcn_readfirstlane(tid >> 6), r32 = lane & 31, hi = lane >> 5;
    const int br = item < 192 ? 0 : (item < 384 ? 1 : 2), rem = br == 2 ? item - 384 : (br == 1 ? item - 192 : item);
    const int bh = br == 2 ? rem >> 3 : rem >> 2, sub = br == 2 ? rem & 7 : rem & 3, b = bh / 6, h = bh % 6;
    const int dil = br == 0 ? 1 : (br == 1 ? 4 : 16), L = SEQ / dil;
    const int ntiles = br == 2 ? 4 : 10, nblk = br == 2 ? 1 : 2;
    const int I0 = br == 0 ? 512 * sub : 0;
    const int resw = br == 0 ? 0 : (br == 1 ? sub : (2 * sub + (wave >> 2)));
    const int iq0 = br == 2 ? 32 * (wave & 3) : I0 + 32 * wave, jlo = br == 2 ? 2 * (wave >> 2) : (wave >> 1), jcnt = br == 2 ? 2 : 3;
    const bf16* QO = (const bf16*)(ws + WS_QO); const bf16* KB = (const bf16*)(ws + WS_KB); const bf16* VB = (const bf16*)(ws + WS_VB);
    bf16* Pout = Pb[0]; float* Lout = Lb[0]; if (br == 1) { Pout = Pb[1]; Lout = Lb[1]; } else if (br == 2) { Pout = Pb[2]; Lout = Lb[2]; }
    const size_t rowbase = (size_t)b * SEQ;
    const LAS float* tb = (const LAS float*)(lds + L_TB) + (h * 3 + br) * 136;
    LAS unsigned char* kdst = lds + L_K + wave * 1024; LAS unsigned char* vdst = lds + L_V + wave * 1024;
#define STAGE_TILE(j, buf) do { \
        const int res_ = br == 0 ? 0 : (br == 1 ? sub : (2 * sub + ((j) >> 1))); \
        const int ikb_ = br == 2 ? 64 * ((j) & 1) : I0 - 64 + 64 * (j); \
        int ik_ = ikb_ + lane; ik_ = ik_ < 0 ? 0 : (ik_ > L - 1 ? L - 1 : ik_); \
        stage16(KB + (rowbase + res_ + dil * ik_) * 384 + h * 64 + wave * 8, kdst + (buf) * 8192); \
        int iv_ = ikb_ + 16 * (wave & 3) + (lane >> 2); iv_ = iv_ < 0 ? 0 : (iv_ > L - 1 ? L - 1 : iv_); \
        stage16(VB + (rowbase + res_ + dil * iv_) * 384 + h * 64 + (wave >> 2) * 32 + (lane & 3) * 8, vdst + (buf) * 8192); } while (0)
    for (int j = 0; j < DP; ++j) STAGE_TILE(j, j);
    const bf16* qbase = QO + (rowbase + resw + (size_t)dil * (iq0 + r32)) * 1024 + 256 + h * 64 + 8 * hi;
    bf16x8 qf[4], qn[4];
#pragma unroll
    for (int s = 0; s < 4; ++s) { qf[s] = *(const bf16x8*)(qbase + 16 * s); qn[s] = nblk == 2 ? *(const bf16x8*)(qbase + (size_t)dil * 256 * 1024 + 16 * s) : qf[s]; }
    asm volatile("" : "+v"(qf[0]), "+v"(qf[1]), "+v"(qf[2]), "+v"(qf[3]), "+v"(qn[0]), "+v"(qn[1]), "+v"(qn[2]), "+v"(qn[3]));
    f32x16 o[2];
#pragma unroll
    for (int r = 0; r < 16; ++r) { o[0][r] = 0.f; o[1][r] = 0.f; }
    float lsum = 0.f; const float negref = -refB;
    int iqc = iq0, jl = jlo;
    auto flush = [&](int iqb) {
        float ls = lsum + __shfl_xor(lsum, 32);
        if (hi == 0) Lout[(rowbase + resw + (size_t)dil * (iqb + r32)) * 6 + h] = ls;
        float one[16];
#pragma unroll
        for (int r = 0; r < 16; ++r) one[r] = 1.0f;
        bf16* ob = Pout + h * 64; const size_t rb_ = rowbase + resw; const int dil_ = dil;
        store_tile(lds + L_OST + wave * 4096, o, one, r32, hi, lane, [=](int row) { return ob + (rb_ + (size_t)dil_ * (iqb + row)) * 384; });
    };
#pragma unroll 1
    for (int j = 0; j < ntiles; ++j) {
        ring_wait(ntiles - 1 - j);
        const int cur = j & (NS - 1);
        if (j + DP < ntiles) STAGE_TILE(j + DP, (j + DP) & (NS - 1));
        if (nblk == 2 && j == jlo + 3) {
            flush(iq0);
#pragma unroll
            for (int r = 0; r < 16; ++r) { o[0][r] = 0.f; o[1][r] = 0.f; }
            lsum = 0.f; iqc = iq0 + 256; jl = jlo + 4;
#pragma unroll
            for (int s = 0; s < 4; ++s) qf[s] = qn[s];
        }
        const int ikb = br == 2 ? 64 * (j & 1) : I0 - 64 + 64 * j;
        if (j >= jl && j < jl + jcnt && ikb >= 0 && ikb < L) {
            tile_compute<1>((const LAS char*)(lds + L_K + cur * 8192), (const LAS char*)(lds + L_V + cur * 8192), qf, o, lsum, negref, r32, hi, lane, ikb, iqc + r32, L, tb);
        }
    }
    flush(iqc);
    __syncthreads();
#undef STAGE_TILE
}
__device__ __forceinline__ void finalizeB(int gtid, int nthreads, unsigned char* ws, const bf16* P0, const bf16* P1, const bf16* P2, const float* L0, const float* L1, const float* L2) {
    bf16* QO = (bf16*)(ws + WS_QO);
    for (int i = gtid; i < MT * 48; i += nthreads) {
        const int row = i / 48, c8 = i % 48, h = c8 >> 3;
        const float l = L0[(size_t)row * 6 + h] + L1[(size_t)row * 6 + h] + L2[(size_t)row * 6 + h]; const float rl = 1.0f / l;
        const v4u a = *(const v4u*)(P0 + (size_t)row * 384 + c8 * 8), bq = *(const v4u*)(P1 + (size_t)row * 384 + c8 * 8), c = *(const v4u*)(P2 + (size_t)row * 384 + c8 * 8);
        v4u o;
#pragma unroll
        for (int e = 0; e < 4; ++e) {
            const float lo = (bf2f((bf16)(a[e] & 0xffff)) + bf2f((bf16)(bq[e] & 0xffff)) + bf2f((bf16)(c[e] & 0xffff))) * rl;
            const float hi2 = (bf2f((bf16)(a[e] >> 16)) + bf2f((bf16)(bq[e] >> 16)) + bf2f((bf16)(c[e] >> 16))) * rl;
            o[e] = pk2(lo, hi2);
        }
        *(v4u*)(QO + (size_t)row * 1024 + 256 + c8 * 8) = o;
    }
}
}
#ifndef PROBE_STAGE
#define PROBE_STAGE 0
#endif
namespace cdn {
typedef short bf16x8 __attribute__((ext_vector_type(8)));
typedef short bf16x4 __attribute__((ext_vector_type(4)));
typedef short v4i16 __attribute__((ext_vector_type(4)));
typedef float f32x16 __attribute__((ext_vector_type(16)));
typedef float f32x4v __attribute__((ext_vector_type(4)));
typedef unsigned u32x4 __attribute__((ext_vector_type(4)));
constexpr int P = 144;
constexpr int QS = 0, KS = 9216, VS = 18432, AS = 27648, MS = 36864, TS = 46080, TES = 55296, WSS = 64512, MF = 73728, UF = MF + 8192, UP = 272, GC = UF + 64 * UP, BETA = GC + 256, EG = BETA + 256, EGL = EG + 256, LEND = EGL + 256;
static_assert(LEND <= 131072, "LDS");
__device__ __forceinline__ int crow(int r, int hi) { return (r & 3) + 8 * (r >> 2) + 4 * hi; }
__device__ __forceinline__ unsigned cvtpk(float lo, float hi) { typedef float f2 __attribute__((ext_vector_type(2))); typedef __bf16 b2 __attribute__((ext_vector_type(2))); f2 v = {lo, hi}; b2 b = __builtin_convertvector(v, b2); return __builtin_bit_cast(unsigned, b); }
__device__ __forceinline__ bf16x8 pack8(float a0, float a1, float a2, float a3, float a4, float a5, float a6, float a7) { const u32x4 w = {cvtpk(a0, a1), cvtpk(a2, a3), cvtpk(a4, a5), cvtpk(a6, a7)}; return __builtin_bit_cast(bf16x8, w); }
__device__ __forceinline__ v4i16 vtr(const LAS unsigned char* p) { return __builtin_amdgcn_ds_read_tr16_b64_v4i16((LAS v4i16*)p); }
__device__ __forceinline__ bf16x8 cat4(v4i16 a, v4i16 b) { return (bf16x8){a[0], a[1], a[2], a[3], b[0], b[1], b[2], b[3]}; }
__device__ __forceinline__ bf16x8 ld8(const LAS unsigned char* p) { return *(const LAS bf16x8*)p; }
__device__ __forceinline__ bf16x8 ld44(const LAS unsigned char* p0, const LAS unsigned char* p1) { const v4i16 a = *(const LAS v4i16*)p0, b = *(const LAS v4i16*)p1; return cat4(a, b); }
__device__ __forceinline__ void st_bf(LAS unsigned char* p, float v) { *(LAS unsigned short*)p = (unsigned short)cvtpk(v, v); }
__device__ __forceinline__ void st_bf2(LAS unsigned char* p0, LAS unsigned char* p1, float v0, float v1) { const unsigned w = cvtpk(v0, v1); *(LAS unsigned short*)p0 = (unsigned short)w; *(LAS unsigned short*)p1 = (unsigned short)(w >> 16); }
#define MFMA32(a, b, c) __builtin_amdgcn_mfma_f32_32x32x16_bf16((a), (b), (c), 0, 0, 0)
#define MFMA16(a, b, c) __builtin_amdgcn_mfma_f32_16x16x32_bf16((a), (b), (c), 0, 0, 0)

__device__ __forceinline__ void prep_item(int item, int lane, unsigned char* ws, unsigned char* xs, const float* convw) {
    const int blk = item / 18, hs = item % 18, seg = lane >> 3, g8 = lane & 7;
    const int ch = hs * 64 + g8 * 8;
    const int t0 = (blk & 31) * 64 + seg * 8; const size_t rowb = (size_t)(blk >> 5) * SEQ;
    const bf16* CR = (const bf16*)(ws + WS_CR);
    u32x4 raw[12];
#pragma unroll
    for (int k = 0; k < 12; ++k) { const int t = t0 + k - 2; raw[k] = (t >= 0 && t < SEQ) ? *(const u32x4*)(CR + (rowb + t) * 1152 + ch) : (u32x4){0u, 0u, 0u, 0u}; }
    float w[5][8];
#pragma unroll
    for (int tp = 0; tp < 5; ++tp) { const f32x4v a = *(const f32x4v*)(convw + tp * 1152 + ch), b = *(const f32x4v*)(convw + tp * 1152 + ch + 4);
        w[tp][0] = a[0]; w[tp][1] = a[1]; w[tp][2] = a[2]; w[tp][3] = a[3]; w[tp][4] = b[0]; w[tp][5] = b[1]; w[tp][6] = b[2]; w[tp][7] = b[3]; }
    bf16* dst = (bf16*)(hs < 6 ? xs + XS_QN : (hs < 12 ? xs + XS_KN : ws + WS_VC)) + (hs % 6) * 64 + g8 * 8;
#pragma unroll
    for (int k = 0; k < 8; ++k) {
        float acc[8];
#pragma unroll
        for (int e = 0; e < 8; ++e) acc[e] = 0.f;
#pragma unroll
        for (int tp = 0; tp < 5; ++tp) { const u32x4 r = raw[k + tp];
#pragma unroll
            for (int e = 0; e < 4; ++e) { acc[2 * e] += __builtin_bit_cast(float, r[e] << 16) * w[tp][2 * e]; acc[2 * e + 1] += __builtin_bit_cast(float, r[e] & 0xffff0000u) * w[tp][2 * e + 1]; } }
        float ss = 0.f;
#pragma unroll
        for (int e = 0; e < 8; ++e) { acc[e] = acc[e] * __builtin_amdgcn_rcpf(1.0f + __expf(-acc[e])); ss += acc[e] * acc[e]; }
        float sc = 1.f;
        if (hs < 12) { ss += __shfl_xor(ss, 1); ss += __shfl_xor(ss, 2); ss += __shfl_xor(ss, 4); sc = __builtin_amdgcn_rsqf(ss + 1e-6f) * (hs < 6 ? 0.125f : 1.0f); }
        const u32x4 o = {cvtpk(acc[0] * sc, acc[1] * sc), cvtpk(acc[2] * sc, acc[3] * sc), cvtpk(acc[4] * sc, acc[5] * sc), cvtpk(acc[6] * sc, acc[7] * sc)};
        *(u32x4*)(dst + (rowb + t0 + k) * 384) = o;
    }
}

__device__ __forceinline__ void kk_tile(LAS unsigned char* lds, int p, int MF1, int tl, int lane);
constexpr int QS2 = 0, KS2 = 18432, AS2 = 36864, WS2 = 55296, US2 = 73728, UPB = 136, VS2 = US2 + 2 * 64 * UPB, MS1 = VS2 + 18432, TS1 = MS1 + 9216, TES1 = TS1 + 9216,
              GC2 = TES1 + 9216, BETA2 = GC2 + 512, EG2 = BETA2 + 512, EGL2 = EG2 + 512, LEND2 = EGL2 + 512;
static_assert(LEND2 <= 139264, "LDS (scan)");
__device__ __forceinline__ void kk_tile(LAS unsigned char* lds, int p, int MF1, int tl, int lane) {
    const int ti = tl >= 6 ? 3 : (tl >= 3 ? 2 : (tl >= 1 ? 1 : 0)), tj = tl - ti * (ti + 1) / 2, l15 = lane & 15, g = lane >> 4;
    const LAS unsigned char* ap = lds + KS2 + p * 9216 + (16 * ti + l15) * P + 16 * g; const LAS unsigned char* bp = lds + KS2 + p * 9216 + (16 * tj + l15) * P + 16 * g;
    f32x4v acc = (f32x4v){0.f, 0.f, 0.f, 0.f};
    acc = MFMA16(ld8(ap), ld8(bp), acc); acc = MFMA16(ld8(ap + 64), ld8(bp + 64), acc);
    const int j = 16 * tj + l15, i0 = 16 * ti + 4 * g;
    const float gcj = *(const LAS float*)(lds + GC2 + p * 256 + 4 * j), bj = *(const LAS float*)(lds + BETA2 + p * 256 + 4 * j);
    const f32x4v gci = *(const LAS f32x4v*)(lds + GC2 + p * 256 + 4 * i0);
#pragma unroll
    for (int e = 0; e < 4; ++e) { const int i = i0 + e;
        const float v = (i > j) ? acc[e] * __builtin_amdgcn_exp2f(gci[e] - gcj) * bj : 0.f;
        st_bf(lds + MS1 + i * P + 2 * j, v);
        if (ti == tj) *(LAS float*)(lds + MF1 + ((ti >> 1) * 1024 + (i & 31) * 32 + (j & 31)) * 4) = v; }
}
__device__ constexpr int sub_qoff(int r) { int s = 0; for (int q = 1; q < r; ++q) s += (q + 3) / 4; return s; }
__device__ __forceinline__ void scan_item(LAS unsigned char* lds, int item, int tid, unsigned char* ws, unsigned char* xs) {
    const int lane0 = tid & 63, wave = __builtin_amdgcn_readfirstlane(tid >> 6);
    int lane = lane0, r32 = lane & 31, hi = lane >> 5, g = lane >> 4, l15 = lane & 15;
#define CDN_IDS() do { lane = lane0; asm volatile("" : "+v"(lane)); r32 = lane & 31; hi = lane >> 5; g = lane >> 4; l15 = lane & 15; } while (0)
    const int dir = item & 1, bh = item >> 1, b = bh / 6, h = bh % 6;
    const size_t rowbase = (size_t)b * SEQ;
    const bf16* QN = (const bf16*)(xs + XS_QN) + h * 64; const bf16* KN = (const bf16*)(xs + XS_KN) + h * 64; const bf16* VC = (const bf16*)(ws + WS_VC) + h * 64;
    const float* GT = (const float*)(ws + WS_GT);
    bf16* OUT = dir ? ((bf16*)(ws + WS_QO) + 640 + h * 64) : ((bf16*)(ws + WS_CF) + h * 64); const int opitch = dir ? 1024 : 384;
    for (int i = tid; i < 36864 / 16; i += 512) *(LAS u32x4*)(lds + AS2 + i * 16) = (u32x4){0u, 0u, 0u, 0u};
    for (int i = tid; i < 27648 / 16; i += 512) *(LAS u32x4*)(lds + MS1 + i * 16) = (u32x4){0u, 0u, 0u, 0u};
    f32x4v St[4];
#pragma unroll
    for (int t = 0; t < 4; ++t) St[t] = (f32x4v){0.f, 0.f, 0.f, 0.f};
    const int prow = (tid >> 3) & 31, pc16 = tid & 7;
    u32x4 nq0 = {0u, 0u, 0u, 0u}, nq1 = nq0, nk0 = nq0, nk1 = nq0, nv0 = nq0, nv1 = nq0; float ng = 0.f, nb = 0.f;
#define CDN_PREFETCH(n) do { if (wave < 4) { const int c_ = dir ? 31 - (n) : (n); const size_t t0_ = rowbase + 64 * c_ + (dir ? 63 - prow : prow), t1_ = rowbase + 64 * c_ + (dir ? 31 - prow : 32 + prow); \
        nq0 = *(const u32x4*)(QN + t0_ * 384 + pc16 * 8); nk0 = *(const u32x4*)(KN + t0_ * 384 + pc16 * 8); nv0 = *(const u32x4*)(VC + t0_ * 384 + pc16 * 8); \
        nq1 = *(const u32x4*)(QN + t1_ * 384 + pc16 * 8); nk1 = *(const u32x4*)(KN + t1_ * 384 + pc16 * 8); nv1 = *(const u32x4*)(VC + t1_ * 384 + pc16 * 8); \
        if (wave == 3) { const size_t tg_ = rowbase + 64 * c_ + (dir ? 63 - lane0 : lane0); ng = GT[tg_ * 32 + 12 + dir * 6 + h]; nb = GT[tg_ * 32 + dir * 6 + h]; } } } while (0)
#define CDN_STAGE(pp) do { if (wave < 4) { \
        *(LAS u32x4*)(lds + QS2 + (pp) * 9216 + prow * P + pc16 * 16) = nq0; *(LAS u32x4*)(lds + QS2 + (pp) * 9216 + (32 + prow) * P + pc16 * 16) = nq1; \
        *(LAS u32x4*)(lds + KS2 + (pp) * 9216 + prow * P + pc16 * 16) = nk0; *(LAS u32x4*)(lds + KS2 + (pp) * 9216 + (32 + prow) * P + pc16 * 16) = nk1; \
        *(LAS u32x4*)(lds + VS2 + (pp) * 9216 + prow * P + pc16 * 16) = nv0; *(LAS u32x4*)(lds + VS2 + (pp) * 9216 + (32 + prow) * P + pc16 * 16) = nv1; \
        if (wave == 3) { float x = ng; \
            _Pragma("unroll") for (int off = 1; off < 64; off <<= 1) { const float y = __shfl_up(x, off); if (lane0 >= off) x += y; } \
            const float tot = __shfl(x, 63); const float x2 = x * 1.4426950408889634f, t2 = tot * 1.4426950408889634f; \
            *(LAS float*)(lds + GC2 + (pp) * 256 + 4 * lane0) = x2; *(LAS float*)(lds + BETA2 + (pp) * 256 + 4 * lane0) = nb; \
            *(LAS float*)(lds + EG2 + (pp) * 256 + 4 * lane0) = __builtin_amdgcn_exp2f(x2); *(LAS float*)(lds + EGL2 + (pp) * 256 + 4 * lane0) = __builtin_amdgcn_exp2f(t2 - x2); } } } while (0)
    CDN_PREFETCH(0);
    CDN_STAGE(0);
    CDN_PREFETCH(1);
    __syncthreads();
#pragma unroll 1
    for (int it = 0; it <= 32; ++it) {
        const int p = it & 1, q = p ^ 1;
        const int MF1 = US2 + p * 64 * UPB;
        CDN_IDS();
        bf16x8 vs0 = {0, 0, 0, 0, 0, 0, 0, 0}, vs1 = vs0, vb0 = vs0, vb1 = vs0, Sb0 = vs0, Sb1 = vs0;
        if (wave >= 4) {
            if (it < 32) { kk_tile(lds, p, MF1, wave - 4, lane); kk_tile(lds, p, MF1, wave, lane); }
        } else {
#pragma unroll 1
            for (int rp_ = 0; rp_ < (PROBE_STAGE == 6 ? 2 : 1); ++rp_)
            if (it >= 1) {
                const int e = 16 * wave + l15, n = it - 1;
                const LAS unsigned char* Qb = lds + QS2 + q * 9216; const LAS unsigned char* Kb = lds + KS2 + q * 9216; const LAS unsigned char* Ab = lds + AS2 + q * 9216;
                const LAS unsigned char* Wb = lds + WS2 + q * 9216; const LAS unsigned char* Ub = lds + US2 + q * 64 * UPB; const LAS unsigned char* EGb = lds + EG2 + q * 256; const LAS unsigned char* ELb = lds + EGL2 + q * 256;
                Sb0 = pack8(St[0][0], St[0][1], St[0][2], St[0][3], St[1][0], St[1][1], St[1][2], St[1][3]);
                Sb1 = pack8(St[2][0], St[2][1], St[2][2], St[2][3], St[3][0], St[3][1], St[3][2], St[3][3]);
                f32x4v vn[4];
#pragma unroll
                for (int t4 = 0; t4 < 4; ++t4) {
                    const LAS unsigned char* wp = Wb + (4 * g + (l15 >> 2)) * P + (16 * t4 + 4 * (l15 & 3)) * 2;
                    f32x4v acc = (f32x4v){0.f, 0.f, 0.f, 0.f};
                    acc = MFMA16(cat4(vtr(wp), vtr(wp + 16 * P)), Sb0, acc);
                    acc = MFMA16(cat4(vtr(wp + 32 * P), vtr(wp + 48 * P)), Sb1, acc);
                    const unsigned long long uu = *(const LAS unsigned long long*)(Ub + e * UPB + 2 * (16 * t4 + 4 * g));
                    const f32x4v u = {__builtin_bit_cast(float, (unsigned)uu << 16), __builtin_bit_cast(float, (unsigned)uu & 0xffff0000u), __builtin_bit_cast(float, (unsigned)(uu >> 32) << 16), __builtin_bit_cast(float, (unsigned)(uu >> 32) & 0xffff0000u)};
                    vn[t4] = u - acc;
                }
                vb0 = pack8(vn[0][0], vn[0][1], vn[0][2], vn[0][3], vn[1][0], vn[1][1], vn[1][2], vn[1][3]);
                vb1 = pack8(vn[2][0], vn[2][1], vn[2][2], vn[2][3], vn[3][0], vn[3][1], vn[3][2], vn[3][3]);
                f32x4v el[4];
#pragma unroll
                for (int t4 = 0; t4 < 4; ++t4) el[t4] = *(const LAS f32x4v*)(ELb + 4 * (16 * t4 + 4 * g));
                vs0 = pack8(vn[0][0] * el[0][0], vn[0][1] * el[0][1], vn[0][2] * el[0][2], vn[0][3] * el[0][3], vn[1][0] * el[1][0], vn[1][1] * el[1][1], vn[1][2] * el[1][2], vn[1][3] * el[1][3]);
                vs1 = pack8(vn[2][0] * el[2][0], vn[2][1] * el[2][1], vn[2][2] * el[2][2], vn[2][3] * el[2][3], vn[3][0] * el[3][0], vn[3][1] * el[3][1], vn[3][2] * el[3][2], vn[3][3] * el[3][3]);
            }
            if (it < 32 && wave == 3) { CDN_IDS(); kk_tile(lds, p, MF1, 8, lane); kk_tile(lds, p, MF1, 9, lane); }
        }
        __syncthreads();
        CDN_IDS();
        if (wave < 4 && it >= 1) {
            {   const int n = it - 1;
                const LAS unsigned char* Qb = lds + QS2 + q * 9216; const LAS unsigned char* Ab = lds + AS2 + q * 9216; const LAS unsigned char* EGb = lds + EG2 + q * 256;
                const int c = dir ? 31 - n : n;
#pragma unroll
                for (int t4 = 0; t4 < 4; ++t4) {
                    const LAS unsigned char* qp = Qb + (16 * t4 + l15) * P + 8 * g; const LAS unsigned char* ap = Ab + (4 * g + (l15 >> 2)) * P + (16 * t4 + 4 * (l15 & 3)) * 2;
                    f32x4v acc = (f32x4v){0.f, 0.f, 0.f, 0.f};
                    acc = MFMA16(Sb0, ld44(qp, qp + 32), acc);
                    acc = MFMA16(Sb1, ld44(qp + 64, qp + 96), acc);
                    const float egi = *(const LAS float*)(EGb + 4 * (16 * t4 + l15));
                    acc = acc * egi;
                    acc = MFMA16(vb0, cat4(vtr(ap), vtr(ap + 16 * P)), acc);
                    acc = MFMA16(vb1, cat4(vtr(ap + 32 * P), vtr(ap + 48 * P)), acc);
                    {   const int i = 16 * t4 + l15; const size_t tok = rowbase + 64 * c + (dir ? 63 - i : i);
                        *(unsigned long long*)(OUT + tok * opitch + 16 * wave + 4 * g) = (unsigned long long)cvtpk(acc[0], acc[1]) | ((unsigned long long)cvtpk(acc[2], acc[3]) << 32); }
                }
            }
            const LAS unsigned char* Kb = lds + KS2 + q * 9216; const float egL = *(const LAS float*)(lds + EG2 + q * 256 + 4 * 63);
#pragma unroll
            for (int t = 0; t < 4; ++t) {
                const LAS unsigned char* kp = Kb + (4 * g + (l15 >> 2)) * P + (16 * t + 4 * (l15 & 3)) * 2;
                f32x4v acc = St[t] * egL;
                acc = MFMA16(cat4(vtr(kp), vtr(kp + 16 * P)), vs0, acc);
                acc = MFMA16(cat4(vtr(kp + 32 * P), vtr(kp + 48 * P)), vs1, acc);
                St[t] = acc;
            }
        }
        if (it < 32 && (wave == 4 || wave == 5)) {
            const int B = wave - 4;
            if (lane < 32) {
                float x[16];
                const LAS float* mf = (const LAS float*)(lds + MF1) + B * 1024 + (g & 1) * (16 * 32 + 16);
                f32x4v mq[36];
#pragma unroll
                for (int r = 1; r < 16; ++r)
#pragma unroll
                    for (int k4 = 0; k4 * 4 < r; ++k4) mq[sub_qoff(r) + k4] = *(const LAS f32x4v*)(mf + r * 32 + 4 * k4);
                asm volatile("s_waitcnt lgkmcnt(0)" ::: "memory");
#define CDN_FNMA(a, mm, xx) asm("v_fma_f32 %0, -%1, %2, %0" : "+v"(a) : "v"(mm), "v"(xx))
#pragma unroll
                for (int r = 0; r < 16; ++r) {
                    float a0 = (r == l15) ? 1.f : 0.f, a1 = 0.f, a2 = 0.f, a3 = 0.f;
#pragma unroll
                    for (int k4 = 0; k4 * 4 < r; ++k4) { const f32x4v mr = mq[sub_qoff(r) + k4];
                        if (4 * k4 + 0 < r) CDN_FNMA(a0, mr[0], x[4 * k4 + 0]); if (4 * k4 + 1 < r) CDN_FNMA(a1, mr[1], x[4 * k4 + 1]); if (4 * k4 + 2 < r) CDN_FNMA(a2, mr[2], x[4 * k4 + 2]); if (4 * k4 + 3 < r) CDN_FNMA(a3, mr[3], x[4 * k4 + 3]); }
                    x[r] = (a0 + a1) + (a2 + a3);
                }
#undef CDN_FNMA
                const int jc0 = 32 * B + lane; const float eg0 = *(const LAS float*)(lds + EG2 + p * 256 + 4 * jc0);
#pragma unroll
                for (int r = 0; r < 16; ++r) { const int i = 32 * B + 16 * (g & 1) + r; st_bf2(lds + TS1 + i * P + 2 * jc0, lds + TES1 + i * P + 2 * jc0, x[r], x[r] * eg0); }
            }
            const bool valid = r32 < 16;
            f32x16 zero;
#pragma unroll
            for (int r = 0; r < 16; ++r) zero[r] = 0.f;
            bf16x8 af = ld8(lds + MS1 + (32 * B + 16 + l15) * P + (32 * B + 8 * hi) * 2);
            if (!valid) af = (bf16x8){0, 0, 0, 0, 0, 0, 0, 0};
            const LAS unsigned char* tp = lds + TS1 + (32 * B + 8 * hi + (l15 >> 2)) * P + (32 * B + 16 * ((lane >> 4) & 1) + 4 * (lane & 3)) * 2;
            const bf16x8 bf = cat4(vtr(tp), vtr(tp + 4 * P));
            const f32x16 X = MFMA32(af, bf, zero);
            const LAS unsigned char* t11 = lds + TS1 + (32 * B + 16 + l15) * P + (32 * B + 16 + 4 * hi) * 2;
            bf16x8 a2 = ld44(t11, t11 + 16);
            if (!valid) a2 = (bf16x8){0, 0, 0, 0, 0, 0, 0, 0};
            const f32x16 Y = MFMA32(a2, pack8(X[0], X[1], X[2], X[3], X[4], X[5], X[6], X[7]), zero);
            const int jc = 32 * B + r32; const float egj = *(const LAS float*)(lds + EG2 + p * 256 + 4 * (jc & 63));
            if (valid) {
#pragma unroll
                for (int r = 0; r < 8; ++r) { const int i = 32 * B + 16 + crow(r, hi); st_bf2(lds + TS1 + i * P + 2 * jc, lds + TES1 + i * P + 2 * jc, -Y[r], -Y[r] * egj); }
            }
        }
        __syncthreads();
        CDN_IDS();
        if (it < 32 && wave < 3) {
                const int I = wave > 0, J = wave > 1;
                f32x16 acc;
#pragma unroll
                for (int r = 0; r < 16; ++r) acc[r] = 0.f;
                const LAS unsigned char* ap = lds + QS2 + p * 9216 + (32 * I + r32) * P + 16 * hi; const LAS unsigned char* bp = lds + KS2 + p * 9216 + (32 * J + r32) * P + 16 * hi;
#pragma unroll
                for (int s = 0; s < 4; ++s) acc = MFMA32(ld8(ap + 32 * s), ld8(bp + 32 * s), acc);
                const int j = 32 * J + r32; const float gcj = *(const LAS float*)(lds + GC2 + p * 256 + 4 * j);
#pragma unroll
                for (int q4 = 0; q4 < 4; ++q4) {
                    const int i0 = 32 * I + 8 * q4 + 4 * hi; const f32x4v gci = *(const LAS f32x4v*)(lds + GC2 + p * 256 + 4 * i0);
                    float av[4];
#pragma unroll
                    for (int e = 0; e < 4; ++e) { const int i = i0 + e; av[e] = (i >= j) ? acc[4 * q4 + e] * __builtin_amdgcn_exp2f(gci[e] - gcj) : 0.f; }
                    *(LAS unsigned long long*)(lds + AS2 + p * 9216 + j * P + 2 * i0) = (unsigned long long)cvtpk(av[0], av[1]) | ((unsigned long long)cvtpk(av[2], av[3]) << 32);
                }
            }
        if (it + 1 < 32) { CDN_STAGE(q); if (it + 2 < 32) CDN_PREFETCH(it + 2); }
        if (it < 32 && wave >= 4) {
            const int ct = wave - 4; const int R = ct < 2 ? VS2 + p * 9216 : KS2 + p * 9216, coff = 32 * (ct & 1), TA = ct < 2 ? TS1 : TES1;
            const LAS unsigned char* rp = lds + R + (8 * hi + (l15 >> 2)) * P + (coff + 16 * ((lane >> 4) & 1) + 4 * (lane & 3)) * 2;
            f32x16 X0, Y, Z;
#pragma unroll
            for (int r = 0; r < 16; ++r) { X0[r] = 0.f; Y[r] = 0.f; Z[r] = 0.f; }
#pragma unroll
            for (int s = 0; s < 2; ++s) X0 = MFMA32(ld8(lds + TA + r32 * P + (16 * s + 8 * hi) * 2), cat4(vtr(rp + 16 * s * P), vtr(rp + (16 * s + 4) * P)), X0);
#pragma unroll
            for (int s = 0; s < 2; ++s) Z = MFMA32(ld8(lds + TA + (32 + r32) * P + (32 + 16 * s + 8 * hi) * 2), cat4(vtr(rp + (32 + 16 * s) * P), vtr(rp + (32 + 16 * s + 4) * P)), Z);
            { const LAS unsigned char* mp = lds + MS1 + (32 + r32) * P + 8 * hi;
              Y = MFMA32(ld44(mp, mp + 16), pack8(X0[0], X0[1], X0[2], X0[3], X0[4], X0[5], X0[6], X0[7]), Y);
              Y = MFMA32(ld44(mp + 32, mp + 48), pack8(X0[8], X0[9], X0[10], X0[11], X0[12], X0[13], X0[14], X0[15]), Y); }
            { const LAS unsigned char* t1 = lds + TS1 + (32 + r32) * P + 64 + 8 * hi;
              Z = MFMA32(ld44(t1, t1 + 16), pack8(-Y[0], -Y[1], -Y[2], -Y[3], -Y[4], -Y[5], -Y[6], -Y[7]), Z);
              Z = MFMA32(ld44(t1 + 32, t1 + 48), pack8(-Y[8], -Y[9], -Y[10], -Y[11], -Y[12], -Y[13], -Y[14], -Y[15]), Z); }
            const int col = coff + r32;
#pragma unroll
            for (int half = 0; half < 2; ++half)
#pragma unroll
                for (int q4 = 0; q4 < 4; ++q4) {
                    const int i0 = 32 * half + 8 * q4 + 4 * hi; const f32x4v bi = *(const LAS f32x4v*)(lds + BETA2 + p * 256 + 4 * i0);
                    f32x4v v;
#pragma unroll
                    for (int e = 0; e < 4; ++e) v[e] = (half ? Z[4 * q4 + e] : X0[4 * q4 + e]) * bi[e];
                    if (ct < 2) *(LAS unsigned long long*)(lds + US2 + p * 64 * UPB + col * UPB + 2 * i0) = (unsigned long long)cvtpk(v[0], v[1]) | ((unsigned long long)cvtpk(v[2], v[3]) << 32);
                    else *(LAS unsigned long long*)(lds + WS2 + p * 9216 + col * P + 2 * i0) = (unsigned long long)cvtpk(v[0], v[1]) | ((unsigned long long)cvtpk(v[2], v[3]) << 32);
                }
        }
        __syncthreads();
    }
#undef CDN_PREFETCH
#undef CDN_STAGE
#undef CDN_IDS
}

__device__ __forceinline__ void finalize_bc(int gtid, int nthreads, unsigned char* ws, unsigned char* xs, const float* outg, bf16* OBb, bf16* OBc, int opitch) {
    bf16* QO = (bf16*)(ws + WS_QO);
    const bf16 *P0 = (const bf16*)(ws + WS_P0), *P1 = (const bf16*)(ws + WS_P1), *P2 = (const bf16*)(ws + WS_P2);
    const float *L0 = (const float*)(xs + XS_L0), *L1 = (const float*)(xs + XS_L1), *L2 = (const float*)(xs + XS_L2);
    const bf16 *CF = (const bf16*)(ws + WS_CF), *CZ = (const bf16*)(ws + WS_CZ);
    constexpr int UN = 3;
    static_assert((MT * 48) % UN == 0, "finalize");
#pragma unroll 1
    for (int i0 = gtid; i0 < MT * 48; i0 += UN * nthreads) {
        v4u a[UN], bq[UN], c[UN], f[UN], bw[UN], z[UN]; float l[UN];
#pragma unroll
        for (int k = 0; k < UN; ++k) { const int i = i0 + k * nthreads; const bool ok = i < MT * 48; const int ii = ok ? i : gtid; const int row = ii / 48, c8 = ii % 48, h = c8 >> 3;
            l[k] = L0[(size_t)row * 6 + h] + L1[(size_t)row * 6 + h] + L2[(size_t)row * 6 + h];
            a[k] = *(const v4u*)(P0 + (size_t)row * 384 + c8 * 8); bq[k] = *(const v4u*)(P1 + (size_t)row * 384 + c8 * 8); c[k] = *(const v4u*)(P2 + (size_t)row * 384 + c8 * 8);
            f[k] = *(const v4u*)(CF + (size_t)row * 384 + c8 * 8); bw[k] = *(const v4u*)(QO + (size_t)row * 1024 + 640 + c8 * 8); z[k] = *(const v4u*)(CZ + (size_t)row * 384 + c8 * 8); }
#pragma unroll
        for (int k = 0; k < UN; ++k) { const int i = i0 + k * nthreads; const bool ok = i < MT * 48; const int ii = ok ? i : gtid; const int row = ii / 48, c8 = ii % 48;
            {
                const float rl = 1.0f / l[k]; v4u o;
#pragma unroll
                for (int e = 0; e < 4; ++e) {
                    const float lo = (__builtin_bit_cast(float, a[k][e] << 16) + __builtin_bit_cast(float, bq[k][e] << 16) + __builtin_bit_cast(float, c[k][e] << 16)) * rl;
                    const float hi2 = (__builtin_bit_cast(float, a[k][e] & 0xffff0000u) + __builtin_bit_cast(float, bq[k][e] & 0xffff0000u) + __builtin_bit_cast(float, c[k][e] & 0xffff0000u)) * rl;
                    o[e] = pk2(lo, hi2);
                }
                if (ok) *(v4u*)(OBb + (size_t)row * opitch + c8 * 8) = o;
            }
            {
                float t[8]; float ss = 0.f;
#pragma unroll
                for (int e = 0; e < 4; ++e) { t[2 * e] = __builtin_bit_cast(float, f[k][e] << 16) + __builtin_bit_cast(float, bw[k][e] << 16); t[2 * e + 1] = __builtin_bit_cast(float, f[k][e] & 0xffff0000u) + __builtin_bit_cast(float, bw[k][e] & 0xffff0000u);
                    ss += t[2 * e] * t[2 * e] + t[2 * e + 1] * t[2 * e + 1]; }
                ss += __shfl_xor(ss, 1); ss += __shfl_xor(ss, 2); ss += __shfl_xor(ss, 4);
                const float rs = __builtin_amdgcn_rsqf(ss * (1.0f / 64.0f) + 1e-6f);
                const float* gp = outg + (c8 & 7) * 8;
                v4u o;
#pragma unroll
                for (int e = 0; e < 4; ++e) o[e] = pk2(t[2 * e] * rs * gp[2 * e] * __builtin_bit_cast(float, z[k][e] << 16), t[2 * e + 1] * rs * gp[2 * e + 1] * __builtin_bit_cast(float, z[k][e] & 0xffff0000u));
                if (ok) *(v4u*)(OBc + (size_t)row * opitch + c8 * 8) = o;
            }
        }
    }
}
}
#define XB_TMO      128
#define XB_XCNT(j)  (256  + 64 * (j))
#define XB_XSUB(j)  (1280 + 64 * (j))
#define XB_XGEN(j)  (2304 + 64 * (j))
#define XB_TOP      3328
#define XB_TOPGEN   3392
#define XCD_BAR_WORDS 3456
#define XB_SPIN_CAP (1u << 24)

__device__ __forceinline__ unsigned xb_ld(unsigned* p)              { return __hip_atomic_load(p, __ATOMIC_RELAXED, __HIP_MEMORY_SCOPE_AGENT); }
__device__ __forceinline__ unsigned xb_add(unsigned* p, unsigned v) { return __hip_atomic_fetch_add(p, v, __ATOMIC_RELAXED, __HIP_MEMORY_SCOPE_AGENT); }
__device__ __forceinline__ unsigned xb_xcc_id() { return (unsigned)__builtin_amdgcn_s_getreg((3 << 11) | 20) & 0xFu; }
#define XB_SPIN(cond, bar) do { unsigned _sp = 0; while (cond) { __builtin_amdgcn_s_sleep(1); \
    if ((++_sp & 255u) == 0u) { if (xb_ld(&(bar)[XB_TMO])) break; if (_sp > XB_SPIN_CAP) { atomicAdd(&(bar)[XB_TMO], 1u); break; } } } } while (0)

struct XcdBarrier {
    unsigned* bar; unsigned x;
    volatile LAS unsigned* st;
};

__device__ __forceinline__ XcdBarrier xcd_barrier_post(unsigned* bar, volatile LAS unsigned* st) {
    XcdBarrier b; b.bar = bar; b.x = xb_xcc_id(); b.st = st;
    if (threadIdx.x == 0) (void)xb_add(&bar[XB_XCNT(b.x)], 1u);
    return b;
}
__device__ __forceinline__ void xcd_barrier_complete(unsigned* bar, unsigned x, unsigned& nloc, unsigned& nx) {
    const unsigned G = gridDim.x * gridDim.y * gridDim.z;
    unsigned sum, cnt, mine, sp = 0u;
    for (;;) {
        sum = 0u; cnt = 0u; mine = 0u;
#pragma unroll
        for (unsigned j = 0; j < 16; ++j) { const unsigned c = xb_ld(&bar[XB_XCNT(j)]); sum += c; cnt += (c > 0u) ? 1u : 0u; mine = (j == x) ? c : mine; }
        if (sum == G) break;
        __builtin_amdgcn_s_sleep(1);
        if ((++sp & 255u) == 0u) { if (xb_ld(&bar[XB_TMO])) break; if (sp > XB_SPIN_CAP) { atomicAdd(&bar[XB_TMO], 1u); break; } }
    }
    nloc = mine > 0u ? mine : 1u; nx = cnt > 0u ? cnt : 1u;
}

__device__ __forceinline__ void xcd_barrier(const XcdBarrier& b) {
    asm volatile("s_waitcnt vmcnt(0)" ::: "memory");
    __syncthreads();
    if (threadIdx.x == 0) {
        unsigned* bar = b.bar;
        __builtin_amdgcn_s_waitcnt(0);
        unsigned nloc = b.st[0], nx = b.st[1];
        if (nloc == 0u) { xcd_barrier_complete(bar, b.x, nloc, nx); b.st[0] = nloc; b.st[1] = nx; }
        const unsigned old = xb_add(&bar[XB_XSUB(b.x)], 1u);
        const unsigned gen = old / nloc;
        if (old + 1u == (gen + 1u) * nloc) {
            __builtin_amdgcn_fence(__ATOMIC_RELEASE, "agent");
            asm volatile("s_waitcnt vmcnt(0)" ::: "memory");
            const unsigned og = xb_add(&bar[XB_TOP], 1u);
            const unsigned tg = og / nx;
            if (og + 1u == (tg + 1u) * nx) xb_add(&bar[XB_TOPGEN], 1u);
            else XB_SPIN(xb_ld(&bar[XB_TOPGEN]) == tg, bar);
            __builtin_amdgcn_fence(__ATOMIC_ACQUIRE, "agent");
            xb_add(&bar[XB_XGEN(b.x)], 1u);
            asm volatile("s_waitcnt vmcnt(0)" ::: "memory");
        } else {
            XB_SPIN(xb_ld(&bar[XB_XGEN(b.x)]) == gen, bar);
            __builtin_amdgcn_fence(__ATOMIC_ACQUIRE, "agent");
            asm volatile("s_waitcnt vmcnt(0)" ::: "memory");
        }
    }
    __syncthreads();
}
constexpr int RING_BYTES = 139264, LDSCTL_OFF = RING_BYTES, MISC_OFF = LDSCTL_OFF + 320, LDS_BYTES = 147456;
constexpr int CW_TMO = 0, CW_BAR = 4096;
typedef GAS unsigned gu32;
#define RLX_AGENT __ATOMIC_RELAXED, __HIP_MEMORY_SCOPE_AGENT
#ifndef PROBE_MASK
#define PROBE_MASK 0
#endif
constexpr int popc9(int m) { int c = 0; for (int k = 0; k < 9; ++k) c += (m >> k) & 1; return c; }
constexpr int PH_PER_LAYER = 9 + popc9(PROBE_MASK), NPHASE = 1 + PH_PER_LAYER * DEPTH;
__device__ __forceinline__ int dup_at(int p) { int q = 0; for (int k = 0; k < 9; ++k) { const int n = 1 + ((PROBE_MASK >> k) & 1); if (p < q + n) return p - q; q += n; } return 0; }
#ifndef PROBE_SUB
#define PROBE_SUB 0
#endif
__device__ __forceinline__ int kind_at(int p) { int q = 0; for (int k = 0; k < 9; ++k) { const int n = 1 + ((PROBE_MASK >> k) & 1); if (p < q + n) return k; q += n; } return 8; }

__device__ __forceinline__ int mk_lane_id() { int l; asm volatile("v_mbcnt_lo_u32_b32 %0, -1, 0\n\tv_mbcnt_hi_u32_b32 %0, -1, %0" : "=v"(l)); return l; }
__global__ void __launch_bounds__(512, 2) mk_fwd(MKArgs a) {
    extern __shared__ __attribute__((aligned(16))) unsigned char lds_raw[];
    LAS unsigned char* lds = (LAS unsigned char*)lds_raw;
    volatile LAS unsigned* MISC = (volatile LAS unsigned*)(lds + MISC_OFF);
    const int tid0 = threadIdx.x;
    const int wave0 = __builtin_amdgcn_readfirstlane(tid0 >> 6);
    const int G = gridDim.x;
    unsigned char* ws = a.ws;
    for (int u = tid0; u < (LDS_BYTES - LDSCTL_OFF) / 4; u += 512) ((LAS unsigned*)(lds + LDSCTL_OFF))[u] = 0u;
    __syncthreads();
    const int lo = a.ph_lo, hi = a.ph_hi;
    XcdBarrier bar = xcd_barrier_post((unsigned*)(ws + WS_CTL) + CW_BAR + lo * 4096, MISC + 8);
#pragma unroll 1
    for (int ph = lo; ph < hi; ++ph) {
#define MK_TID() (wave0 * 64 + mk_lane_id())
        const int wave = wave0;
        int bid = blockIdx.x; asm volatile("" : "+s"(bid));
        const int l = ph == 0 ? 0 : (ph - 1) / PH_PER_LAYER, kind = ph == 0 ? -1 : kind_at((ph - 1) % PH_PER_LAYER);
        bf16* HB = (bf16*)(ws + WS_HB); bf16* HID = (bf16*)(ws + WS_HID);
        unsigned char* wl = ws + WS_W + (size_t)l * W_LAYER;
        const float* pb = (const float*)(ws + WS_PB) + l * PB_LAYER;
        if (kind == -1) {
#ifndef PROBE_PRO
#define PROBE_PRO 0
#endif
#pragma unroll 1
            for (int rep = 0; rep <= PROBE_PRO; ++rep)
            prologue_phase((const CAS cfp*)__builtin_amdgcn_kernarg_segment_ptr(), ws, lds, bid * 8 + wave, G * 8, wave, mk_lane_id());
        } else if (kind == 0 || kind == 7) {
            pg8::Gemm g{HB, (const bf16*)(wl + (kind ? OFF_GU2 : OFF_GU1)), MT, NGU, DM}; pg8::SplitOrder S; S.init(MT, NGU, G, bid);
            pg8::EpiSwiGLU E{ws, DFF, 0}; E.tbl = pg8::fill_rstd(lds, S, (const float*)(ws + WS_SSQ), MK_TID(), 8);
            pg8::gemm_phase<pg8::EpiSwiGLU, pg8::SplitOrder, true, true, true>(lds, g, S, E, MK_TID());
        } else if (kind == 1 || kind == 8) {
            pg8::Gemm g{HID, (const bf16*)(wl + (kind == 8 ? OFF_D2 : OFF_D1)), MT, DM, DFF}; pg8::StaticOrder S; S.init(MT, DM, G, bid);
            pg8::EpiResid E{(l == 0 && kind == 1) ? a.in[0] : nullptr, (l == DEPTH - 1 && kind == 8) ? a.out : nullptr, ws, 0.5f, 0};
            pg8::gemm_phase<pg8::EpiResid, pg8::StaticOrder, true, true>(lds, g, S, E, MK_TID());
        } else if (kind == 2) {
            pg8::Gemm g{HB, (const bf16*)(wl + OFF_IN), MT, NIN_MAIN, DM}; pg8::StaticOrder S; S.init(MT, NIN_MAIN, G, bid);
            pg8::EpiInProj E{ws, l, 0, 0}; pg8::fill_params<int>(lds, pb, MK_TID()); E.tbl = pg8::fill_rstd(lds, S, (const float*)(ws + WS_SSQ), MK_TID(), 6);
            pg8::gemm_phase<pg8::EpiInProj, pg8::StaticOrder, true, true>(lds, g, S, E, MK_TID());
        } else if (kind == 3) {
#pragma unroll 1
            for (int it = bid * 8 + wave; it < 256 * 18; it += G * 8) cdn::prep_item(it, mk_lane_id(), ws, (unsigned char*)a.out, pb + PB_CONV);
            if (l == 0) {   const float refA = pb[PB_REFA];
#pragma unroll 1
                for (int ia = bid; ia < 256; ia += G) att::itemA(lds, ia, MK_TID(), ws, refA, (bf16*)(ws + WS_QO), 1024);
            }
        } else if (kind == 4) {
            const float refB = pb[PB_REFB]; const float* tbg = (const float*)(ws + WS_PB) + PB_TB;
            const int isdup = dup_at((ph - 1) % PH_PER_LAYER); const bool do_scan = !(isdup && PROBE_SUB == 2), do_b = !(isdup && PROBE_SUB == 1);
            if (do_scan) {
#pragma unroll 1
            for (int it = bid; it < 96; it += G) cdn::scan_item(lds, it, MK_TID(), ws, (unsigned char*)a.out);
            }
            const int nbw = G > 96 ? G - 96 : G, st = G > 96 ? bid - 96 : bid;
            if (st >= 0 && do_b) {
                {
                    pg8::Gemm g{HB, (const bf16*)(wl + OFF_IN) + (size_t)NIN_MAIN * DM, MT, 256, DM}; pg8::StaticOrder S; S.init(MT, 256, nbw > 96 ? nbw - 96 : nbw, nbw > 96 ? (st >= 96 ? st - 96 : 1 << 20) : st);
                    pg8::EpiInProj E{ws, l, 48, 0}; pg8::fill_params<int>(lds, pb, MK_TID()); E.tbl = pg8::fill_rstd(lds, S, (const float*)(ws + WS_SSQ), MK_TID(), 6);
                    pg8::gemm_phase<pg8::EpiInProj, pg8::StaticOrder, true, true>(lds, g, S, E, MK_TID());
                }
                if (l != 0) { const float refA = pb[PB_REFA];
#pragma unroll 1
                    for (int ia = st; ia < 256; ia += nbw) att::itemA(lds, ia, MK_TID(), ws, refA, (bf16*)(ws + WS_QO), 1024); }
                att::fill_tables(lds, tbg, MK_TID());
                {   bf16* const Pb[3] = {(bf16*)(ws + WS_P0), (bf16*)(ws + WS_P1), (bf16*)(ws + WS_P2)};
                    float* const Lb[3] = {(float*)((unsigned char*)a.out + XS_L0), (float*)((unsigned char*)a.out + XS_L1), (float*)((unsigned char*)a.out + XS_L2)};
                    const bool bal = nbw == 160, isP = st < 96; const int q = st - 96, nl = isP ? 2 : 3, ns = isP ? (l == 0 ? 4 : 2) : (l == 0 ? 0 : 3);
                    const int cnt = bal ? nl + ns : (768 - st + nbw - 1) / nbw;
#pragma unroll 1
                    for (int k = 0; k < cnt; ++k) {
                        const int ib = !bal ? st + k * nbw : (k < nl ? (isP ? st + 96 * k : 192 + q + 64 * k) : (isP ? 384 + st + 96 * (k - nl) : 576 + q + 64 * (k - nl)));
                        att::itemB(lds, ib, MK_TID(), ws, refB, Pb, Lb); }
                }
                if (l == 0 && dup_at((ph - 1) % PH_PER_LAYER) == 0)
                    convert_weights((const CAS cfp*)__builtin_amdgcn_kernarg_segment_ptr(), ws, lds, st * 8 + wave, nbw * 8, wave, mk_lane_id(), 1);
            }
        } else if (kind == 5) {
            const bool scr5 = (PROBE_MASK & 32) && dup_at((ph - 1) % PH_PER_LAYER) == 0;
            cdn::finalize_bc(bid * 512 + MK_TID(), G * 512, ws, (unsigned char*)a.out, pb + PB_OUTG, scr5 ? (bf16*)(ws + WS_VC) : (bf16*)(ws + WS_QO) + 256, scr5 ? (bf16*)(ws + WS_VC) : (bf16*)(ws + WS_QO) + 640, scr5 ? 384 : 1024);
        } else {
            pg8::Gemm g{(const bf16*)(ws + WS_QO), (const bf16*)(wl + OFF_O), MT, DM, DM}; pg8::StaticOrder S; S.init(MT, DM, G, bid);
            pg8::EpiResid E{nullptr, nullptr, ws, 1.0f, 0};
            pg8::gemm_phase<pg8::EpiResid, pg8::StaticOrder, true, true>(lds, g, S, E, MK_TID());
        }
        if (ph + 1 < hi) xcd_barrier(bar);
    }
}

extern "C" void kernel_launch(void* const* d_in, const int* in_sizes, int n_in, void* d_out, int out_size, void* d_ws, size_t ws_size, hipStream_t stream) {
    static int grid = 0;
    if (grid == 0) {
        if (n_in != 21 || out_size != MT * DM || ws_size < WS_END) { fprintf(stderr, "kernel_launch: unexpected problem shape (n_in %d out %d ws %zu)\n", n_in, out_size, ws_size); grid = -1; return; }
        int dev = 0, cus = 0, per_cu = 0;
        if (hipGetDevice(&dev) != hipSuccess || hipDeviceGetAttribute(&cus, hipDeviceAttributeMultiprocessorCount, dev) != hipSuccess) { grid = -1; return; }
        if (hipFuncSetAttribute((const void*)mk_fwd, hipFuncAttributeMaxDynamicSharedMemorySize, LDS_BYTES) != hipSuccess) { fprintf(stderr, "kernel_launch: hipFuncSetAttribute failed\n"); grid = -1; return; }
        if (hipOccupancyMaxActiveBlocksPerMultiprocessor(&per_cu, (const void*)mk_fwd, 512, LDS_BYTES) != hipSuccess || per_cu < 1) { fprintf(stderr, "kernel_launch: occupancy query says %d\n", per_cu); per_cu = 1; }
        (void)hipGetLastError();
        grid = cus;
    }
    if (grid < 0) return;
    (void)hipMemsetAsync((char*)d_ws + WS_CTL, 0, WS_PB, stream);
    MKArgs a; memset(&a, 0, sizeof a);
    for (int i = 0; i < 21; ++i) a.in[i] = (const float*)d_in[i];
    a.out = (float*)d_out; a.ws = (unsigned char*)d_ws;
    a.ph_lo = 0; a.ph_hi = NPHASE;
    hipLaunchKernelGGL(mk_fwd, dim3(grid), dim3(512), LDS_BYTES, stream, a);
}
```

```cpp
#include <hip/hip_runtime.h>
#include <cstdio>
#include <cstdint>
#include <cstring>
constexpr int BATCH = 8, SEQ = 2048, DM = 1024, MT = BATCH * SEQ, DFF = 2816, NIN = 3224, NINP = 3328, NIN_MAIN = 3072, DEPTH = 2;
constexpr int NGU = 2 * DFF;
typedef unsigned short bf16;
typedef unsigned v4u __attribute__((ext_vector_type(4)));
typedef float f32x4 __attribute__((ext_vector_type(4)));
#define LAS __attribute__((address_space(3)))
#define GAS __attribute__((address_space(1)))

constexpr size_t MiB = 1u << 20;
constexpr size_t WS_CTL = 0, CTL_BYTES = 1 * MiB;
constexpr size_t WS_PB = 512 * 1024;
constexpr int PB_AQN = 0, PB_AKN = 64, PB_BQN = 128, PB_BKN = 192, PB_OUTG = 256, PB_ALOG = 320, PB_DTB = 332, PB_REFA = 344, PB_REFB = 345, PB_CONV = 384, PB_LAYER = 6144, PB_REL = 2 * PB_LAYER, PB_TB = PB_REL + 192, PB_FLOATS = PB_TB + 6 * 3 * 136;
constexpr size_t WS_SSQ = 1 * MiB;
constexpr size_t WS_W = 2 * MiB;
constexpr size_t W_GU = (size_t)NGU * DM * 2, W_D = (size_t)DM * DFF * 2, W_IN = (size_t)NINP * DM * 2, W_O = (size_t)DM * DM * 2;
constexpr size_t OFF_GU1 = 0, OFF_D1 = OFF_GU1 + W_GU, OFF_IN = OFF_D1 + W_D, OFF_O = OFF_IN + W_IN, OFF_GU2 = OFF_O + W_O, OFF_D2 = OFF_GU2 + W_GU, W_LAYER = OFF_D2 + W_D;
static_assert(W_LAYER * 2 == 83 * MiB, "weights");
constexpr size_t WS_HB = 85 * MiB;
constexpr size_t WS_R = 117 * MiB;
constexpr size_t WS_HID = WS_R;
constexpr size_t WS_QO = WS_R, WS_KA = WS_QO + 32 * MiB, WS_VA = WS_KA + 4 * MiB, WS_KB = WS_VA + 4 * MiB, WS_VB = WS_KB + 12 * MiB, WS_CR = WS_VB + 12 * MiB,
                 WS_CZ = WS_CR + 36 * MiB, WS_GT = WS_CZ + 12 * MiB, WS_VC = WS_GT + 2 * MiB, WS_CF = WS_VC + 12 * MiB, WS_END = WS_CF + 12 * MiB;
constexpr size_t WS_P0 = WS_CR, WS_P1 = WS_CR + 12 * MiB, WS_P2 = WS_CR + 24 * MiB;
constexpr size_t XS_QN = 0, XS_KN = 12 * MiB, XS_L0 = 24 * MiB, XS_L1 = XS_L0 + 512 * 1024, XS_L2 = XS_L1 + 512 * 1024;
static_assert(WS_END <= 256 * MiB && WS_HID + (size_t)MT * DFF * 2 <= 256 * MiB, "d_ws map");

namespace pg8 {
#define PG8_LAS __attribute__((address_space(3)))
typedef unsigned short bf16_t;
typedef short bf16x8 __attribute__((ext_vector_type(8)));
typedef float f32x4 __attribute__((ext_vector_type(4)));
typedef unsigned u32x4 __attribute__((ext_vector_type(4)));
constexpr int BM = 256, BK = 64, HALF = 128, HTB = HALF * BK * 2  , STAGE_BYTES = 8 * HTB, NXCD = 8, WGM = 8;

__host__ __device__ __forceinline__ int lds_byte(int r, int c) { const int st = (r >> 4) * 2 + (c >> 5), rr = r & 15, cc = c & 31, ob = rr * 64 + cc * 2; return st * 1024 + (ob ^ (((ob >> 9) & 1) << 5)); }
__host__ __device__ __forceinline__ void stage_rc(int b, int& R, int& C) { const int st = b / 1024, sb = b % 1024, swz = sb ^ (((sb >> 9) & 1) << 5); R = (st >> 1) * 16 + swz / 64; C = (st & 1) * 32 + (swz % 64) / 2; }
__host__ __device__ __forceinline__ int perm32(int rho) { const int n = rho >> 4, i = rho & 15; return 8 * (i >> 2) + 4 * n + (i & 3); }

struct Unit { int pm, pn, hm; };
struct Gemm { const bf16_t* A; const bf16_t* Bt; int M, N, K; };

struct StaticOrder {
    int nM, nN, nwg, G, c;
    __host__ __device__ void init(int M, int N, int G_, int c_) { nM = M / BM; nN = N / BM; nwg = nM * nN; G = G_; c = c_; }
    __host__ __device__ bool next(int i, Unit& u) const {
        const long L = (long)i * G + c; if (L >= nwg) return false;
        int wgid = (int)L; { const int q = nwg / NXCD, r = nwg % NXCD, xcd = wgid % NXCD, off = wgid / NXCD; wgid = (xcd < r ? xcd * (q + 1) : r * (q + 1) + (xcd - r) * q) + off; }
        const int nig = WGM * nN, gid = wgid / nig, fm = gid * WGM, gsz = (nM - fm) < WGM ? (nM - fm) : WGM;
        u.pm = fm + ((wgid % nig) % gsz); u.pn = (wgid % nig) / gsz; u.hm = 0; return true;
    }
    __device__ __forceinline__ void a_ready(const Unit&) const {}
    __device__ __forceinline__ void done(const Unit&) const {}
};
struct SplitOrder {
    int nM, nN, nwg, G, c, fullr; bool split, hfirst;
    __host__ __device__ __forceinline__ void init(int M, int N, int G_, int c_) { nM = M / BM; nN = N / BM; nwg = nM * nN; G = G_; c = c_; fullr = nwg / G; split = ((nwg % G) * 2 == G) && (G % (2 * NXCD) == 0) && (nwg % NXCD == 0);
        hfirst = false && split && (((c / NXCD) >> 1) & 1); }
    __host__ __device__ __forceinline__ bool next(int i, Unit& u) const {
        int hm = 0;
        if (split) { if (i > fullr) return false; const int ih = hfirst ? 0 : fullr; if (i == ih) hm = 1 + ((c / NXCD) & 1); else if (hfirst) --i; }
        long L = (long)i * G + c;
        if (hm) L = (long)fullr * G + NXCD * ((c / NXCD) >> 1) + (c % NXCD);
        if (L >= nwg) return false;
        int wgid = (int)L; { const int q = nwg / NXCD, r = nwg % NXCD, xcd = wgid % NXCD, off = wgid / NXCD; wgid = (xcd < r ? xcd * (q + 1) : r * (q + 1) + (xcd - r) * q) + off; }
        const int nig = WGM * nN, gid = wgid / nig, fm = gid * WGM, gsz = (nM - fm) < WGM ? (nM - fm) : WGM;
        u.pm = fm + ((wgid % nig) % gsz); u.pn = (wgid % nig) / gsz; u.hm = hm; return true;
    }
    __device__ __forceinline__ void a_ready(const Unit&) const {}
    __device__ __forceinline__ void done(const Unit&) const {}
};
__device__ __forceinline__ unsigned cvt_pk_bf16(float lo, float hi) { unsigned r; asm volatile("v_cvt_pk_bf16_f32 %0, %1, %2" : "=v"(r) : "v"(lo), "v"(hi)); return r; }
typedef float f32x2 __attribute__((ext_vector_type(2)));
#ifndef PROBE_EPI
#define PROBE_EPI 0
#endif
#ifndef PROBE_EPIX
#define PROBE_EPIX 0
#endif
constexpr float RMS_EPS = 1e-6f;
constexpr int PBL_OFF = 131072 + 6144;
template <class Sched> __device__ __forceinline__ void fill_params(PG8_LAS unsigned char* lds, const float* pbg, int tid) { if (tid < 352) *(PG8_LAS float*)(lds + PBL_OFF + 4 * tid) = pbg[tid]; }
constexpr int RSTD_OFF = 131072;
template <class Sched> __device__ __forceinline__ bool fill_rstd(PG8_LAS unsigned char* lds, const Sched& S, const float* ssq, int tid, int maxu) {
    { Unit u9; if (S.next(maxu, u9)) return false; }
    for (int idx = tid; idx < maxu * 256; idx += 512) { Unit u; if (!S.next(idx >> 8, u)) break;
        const float* p = ssq + (size_t)(u.pm * BM + (idx & 255)) * 16; const f32x4 a = *(const f32x4*)p, b = *(const f32x4*)(p + 4), c = *(const f32x4*)(p + 8), d = *(const f32x4*)(p + 12);
        const float s = (((a[0] + a[1]) + (a[2] + a[3])) + ((b[0] + b[1]) + (b[2] + b[3]))) + (((c[0] + c[1]) + (c[2] + c[3])) + ((d[0] + d[1]) + (d[2] + d[3])));
        *(PG8_LAS float*)(lds + RSTD_OFF + idx * 4) = __builtin_amdgcn_rsqf(s * (1.0f / 1024.0f) + RMS_EPS); }
    __syncthreads();
    return true;
}
__device__ __forceinline__ int pg8_lane_id() { int l; asm volatile("v_mbcnt_lo_u32_b32 %0, -1, 0\n\tv_mbcnt_hi_u32_b32 %0, -1, %0" : "=v"(l)); return l; }
__device__ __forceinline__ float row_rstd(const float* ssq, int row, int fq) {
    const f32x4 p = *(const f32x4*)(ssq + (size_t)row * 16 + 4 * fq);
    float s = (p[0] + p[1]) + (p[2] + p[3]);
    s += __shfl_xor(s, 16); s += __shfl_xor(s, 32);
    return __builtin_amdgcn_rsqf(s * (1.0f / 1024.0f) + RMS_EPS);
}
__device__ __forceinline__ float rstd_of(PG8_LAS unsigned char* lds, const float* ssq, bool tbl, int ui, int lrow, int row, int fq) {
    return tbl ? *(const PG8_LAS float*)(lds + RSTD_OFF + (ui * 256 + lrow) * 4) : row_rstd(ssq, row, fq);
}
__device__ __forceinline__ float silu_f(float x) { return x * __builtin_amdgcn_rcpf(1.0f + __expf(-x)); }

struct EpiSwiGLU {
    static constexpr bool PERM = false, AFTER_DRAIN = false; static constexpr int DUPN = (PROBE_EPI == 1) ? 1 : 0;
    unsigned char* ws; int ldh; int tbl;
    __device__ __forceinline__ void operator()(const f32x4 (&acc)[2][2][4][2], const Unit& u, int wr, int wc, int fr, int fq, int ui, PG8_LAS unsigned char* lds) const {
        asm volatile("" : "+v"(fr), "+v"(fq));
        const int col0 = u.pn * 128 + wc * 32 + 8 * fq;
        const auto hrs = __builtin_amdgcn_make_buffer_rsrc((void*)(ws + WS_HID), 0, MT * DFF * 2, 0x00020000);
        const int hm = u.hm, lr0 = (hm == 2 ? 128 : 0) + wr * (hm ? 32 : 64) + fr, sa = hm ? 64 : 128;
        float rs[2][4];
#pragma unroll
        for (int ai = 0; ai < 2; ++ai)
#pragma unroll
            for (int m = 0; m < 4; ++m) rs[ai][m] = (m < 2 || !hm) ? rstd_of(lds, (const float*)(ws + WS_SSQ), tbl != 0, ui, lr0 + ai * sa + m * 16, u.pm * BM + lr0 + ai * sa + m * 16, fq) : 0.f;
#pragma unroll
        for (int ai = 0; ai < 2; ++ai)
#pragma unroll
            for (int m = 0; m < 4; ++m) if (m < 2 || !hm) {
                const int row = u.pm * BM + lr0 + ai * sa + m * 16;
                const float r = rs[ai][m], nrl = r * -1.4426950408889634f, r2 = r * r;
                f32x4 G0 = acc[ai][0][m][0], G1 = acc[ai][0][m][1], U0 = acc[ai][1][m][0], U1 = acc[ai][1][m][1];
                f32x4 e0 = G0 * nrl, e1 = G1 * nrl;
#pragma unroll
                for (int e = 0; e < 4; ++e) { e0[e] = __builtin_amdgcn_exp2f(e0[e]); e1[e] = __builtin_amdgcn_exp2f(e1[e]); }
                asm volatile("" : "+v"(e0), "+v"(e1));
                f32x4 d0 = e0 + 1.0f, d1 = e1 + 1.0f; const f32x4 p0 = G0 * U0, p1 = G1 * U1;
#pragma unroll
                for (int e = 0; e < 4; ++e) { d0[e] = __builtin_amdgcn_rcpf(d0[e]); d1[e] = __builtin_amdgcn_rcpf(d1[e]); }
                asm volatile("" : "+v"(d0), "+v"(d1));
                const f32x4 h0 = p0 * (d0 * r2), h1 = p1 * (d1 * r2);
                u32x4 w; w.x = cvt_pk_bf16(h0[0], h0[1]); w.y = cvt_pk_bf16(h0[2], h0[3]); w.z = cvt_pk_bf16(h1[0], h1[1]); w.w = cvt_pk_bf16(h1[2], h1[3]);
                __builtin_amdgcn_raw_buffer_store_b128(w, hrs, (unsigned)(row * ldh + col0) * 2u, 0, 16);
                asm volatile("" ::: "memory");
            }
    }
};

struct EpiResid {
    static constexpr bool PERM = false, AFTER_DRAIN = false; static constexpr int DUPN = (PROBE_EPI == 2) ? 1 : 0;
    const float* xin; float* fout; unsigned char* ws; float scale; int pad;
    __device__ __forceinline__ void operator()(const f32x4 (&acc)[2][2][4][2], const Unit& u, int wr, int wc, int fr, int fq, int ui, PG8_LAS unsigned char* lds) const {
        asm volatile("" : "+v"(fr), "+v"(fq));
        const int col0 = u.pn * BM + wc * 32 + 8 * fq; bf16_t* hb = (bf16_t*)(ws + WS_HB); float* ssq = (float*)(ws + WS_SSQ);
        const auto hbrs = __builtin_amdgcn_make_buffer_rsrc((void*)(ws + WS_HB), 0, MT * 1024 * 2, 0x00020000);
        const auto finish = [&](int ai, int m, const f32x4 (&h0)[2], const f32x4 (&h1)[2]) {
            const int row = u.pm * BM + ai * HALF + wr * 64 + m * 16 + fr;
            float ss = 0.f;
#pragma unroll
            for (int bj = 0; bj < 2; ++bj) {
                const size_t off = (size_t)row * 1024 + col0 + bj * HALF;
                const f32x4 o0 = h0[bj] + acc[ai][bj][m][0] * scale, o1 = h1[bj] + acc[ai][bj][m][1] * scale;
                if (fout) { *(f32x4*)(fout + off) = o0; *(f32x4*)(fout + off + 4) = o1; }
                else {
                    u32x4 w; w.x = cvt_pk_bf16(o0[0], o0[1]); w.y = cvt_pk_bf16(o0[2], o0[3]); w.z = cvt_pk_bf16(o1[0], o1[1]); w.w = cvt_pk_bf16(o1[2], o1[3]);
                    __builtin_amdgcn_raw_buffer_store_b128(w, hbrs, (unsigned)off * 2u, 0, 16);
                    ss += (o0[0] * o0[0] + o0[1] * o0[1]) + (o0[2] * o0[2] + o0[3] * o0[3]) + (o1[0] * o1[0] + o1[1] * o1[1]) + (o1[2] * o1[2] + o1[3] * o1[3]);
                }
            }
            if (!fout) { ss += __shfl_xor(ss, 16); ss += __shfl_xor(ss, 32); if (fq == 0) { float* sp_ = ssq + (size_t)row * 16 + u.pn * 4 + wc; asm volatile("global_store_dword %0, %1, off sc1\n\ts_nop 0" :: "v"(sp_), "v"(ss) : "memory"); } }
        };
        if (xin) {
#pragma unroll
            for (int ai = 0; ai < 2; ++ai) {
                f32x4 pre[4][2][2];
#pragma unroll
                for (int m = 0; m < 4; ++m)
#pragma unroll
                    for (int bj = 0; bj < 2; ++bj) { const size_t off = (size_t)(u.pm * BM + ai * HALF + wr * 64 + m * 16 + fr) * 1024 + col0 + bj * HALF; pre[m][bj][0] = *(const f32x4*)(xin + off); pre[m][bj][1] = *(const f32x4*)(xin + off + 4); }
#pragma unroll
                for (int m = 0; m < 4; ++m) { const f32x4 h0[2] = {pre[m][0][0], pre[m][1][0]}, h1[2] = {pre[m][0][1], pre[m][1][1]}; finish(ai, m, h0, h1); }
                asm volatile("" ::: "memory");
            }
        } else {
            u32x4 praw[2][4][2];
#pragma unroll
            for (int ai = 0; ai < 2; ++ai)
#pragma unroll
                for (int m = 0; m < 4; ++m)
#pragma unroll
                    for (int bj = 0; bj < 2; ++bj) praw[ai][m][bj] = *(const u32x4*)(hb + (size_t)(u.pm * BM + ai * HALF + wr * 64 + m * 16 + fr) * 1024 + col0 + bj * HALF);
#pragma unroll
            for (int ai = 0; ai < 2; ++ai)
#pragma unroll
                for (int m = 0; m < 4; ++m) {
                    f32x4 h0[2], h1[2];
#pragma unroll
                    for (int bj = 0; bj < 2; ++bj) { const u32x4 w = praw[ai][m][bj];
                        h0[bj] = (f32x4){__builtin_bit_cast(float, w.x << 16), __builtin_bit_cast(float, w.x & 0xffff0000u), __builtin_bit_cast(float, w.y << 16), __builtin_bit_cast(float, w.y & 0xffff0000u)};
                        h1[bj] = (f32x4){__builtin_bit_cast(float, w.z << 16), __builtin_bit_cast(float, w.z & 0xffff0000u), __builtin_bit_cast(float, w.w << 16), __builtin_bit_cast(float, w.w & 0xffff0000u)}; }
                    finish(ai, m, h0, h1);
                    asm volatile("" ::: "memory");
                }
        }
    }
};

constexpr float ATT_C2 = 0.125f * 1.4426950408889634f;
struct EpiInProj {
    static constexpr bool PERM = false, AFTER_DRAIN = false; static constexpr int DUPN = (PROBE_EPI == 3) ? 1 : 0;
    unsigned char* ws; int layer; int hs_off; int tbl;
    __device__ __forceinline__ void operator()(const f32x4 (&acc)[2][2][4][2], const Unit& u, int wr, int wc, int fr, int fq, int ui, PG8_LAS unsigned char* lds) const {
        asm volatile("" : "+v"(fr), "+v"(fq));
        const int dp = ui >> 16; ui &= 0xffff; const bool st_en = !(PROBE_EPI == 3 && ((PROBE_EPIX == 1 && dp == 1) || (PROBE_EPIX == 6 && dp == 0)) && ((const volatile unsigned*)(ws + WS_CTL))[64] == 0u);
        if (PROBE_EPI == 3 && PROBE_EPIX >= 2 && PROBE_EPIX <= 5 && dp == 1) { const int pn_ = u.pn + (hs_off >> 2); const bool sel = PROBE_EPIX == 2 ? pn_ == 11 : (PROBE_EPIX == 3 ? pn_ < 2 : (PROBE_EPIX == 4 ? (pn_ >= 2 && pn_ < 5) : (pn_ >= 5 && pn_ < 11))); if (!sel) return; }
        const int hs = u.pn * 4 + wc + hs_off;
        if (hs >= 51) return;
        const float* ssq = (const float*)(ws + WS_SSQ); const PG8_LAS float* pb = (const PG8_LAS float*)(lds + PBL_OFF);
        if (hs == 44) {
            f32x4 al0, al1, db0, db1;
#pragma unroll
            for (int j = 0; j < 8; ++j) { const int d = 8 * fq + j - 12; const bool v = (d >= 0 && d < 12); const float a_ = v ? -__expf(pb[PB_ALOG + (v ? d : 0)]) : 0.f, b_ = v ? pb[PB_DTB + (v ? d : 0)] : 0.f;
                if (j < 4) { al0[j] = a_; db0[j] = b_; } else { al1[j - 4] = a_; db1[j - 4] = b_; } }
#pragma unroll
            for (int ai = 0; ai < 2; ++ai)
#pragma unroll
                for (int m = 0; m < 4; ++m) {
                    const int row = u.pm * BM + ai * HALF + wr * 64 + m * 16 + fr;
                    const float r = rstd_of(lds, ssq, tbl != 0, ui, ai * HALF + wr * 64 + m * 16 + fr, row, fq);
                    const f32x4 z0 = acc[ai][0][m][0] * r + db0, z1 = acc[ai][0][m][1] * r + db1;
                    f32x4 t0, t1;
#pragma unroll
                    for (int e = 0; e < 4; ++e) { t0[e] = __builtin_amdgcn_exp2f(fabsf(z0[e]) * -1.4426950408889634f); t1[e] = __builtin_amdgcn_exp2f(fabsf(z1[e]) * -1.4426950408889634f); }
                    asm volatile("" : "+v"(t0), "+v"(t1));
                    const f32x4 d0 = t0 + 1.0f, d1 = t1 + 1.0f;
                    f32x4 rc0, rc1, lg0, lg1;
#pragma unroll
                    for (int e = 0; e < 4; ++e) { rc0[e] = __builtin_amdgcn_rcpf(d0[e]); rc1[e] = __builtin_amdgcn_rcpf(d1[e]); }
#pragma unroll
                    for (int e = 0; e < 4; ++e) { lg0[e] = __builtin_amdgcn_logf(d0[e]); lg1[e] = __builtin_amdgcn_logf(d1[e]); }
                    asm volatile("" : "+v"(rc0), "+v"(rc1), "+v"(lg0), "+v"(lg1));
                    f32x4 o0, o1;
#pragma unroll
                    for (int e = 0; e < 4; ++e) {
                        const float sg0 = (z0[e] >= 0.f ? 1.0f : t0[e]) * rc0[e], sg1 = (z1[e] >= 0.f ? 1.0f : t1[e]) * rc1[e];
                        const float sp0 = fmaxf(z0[e], 0.f) + lg0[e] * 0.6931471805599453f, sp1 = fmaxf(z1[e], 0.f) + lg1[e] * 0.6931471805599453f;
                        o0[e] = (8 * fq + e < 12) ? sg0 : al0[e] * sp0; o1[e] = (8 * fq + 4 + e < 12) ? sg1 : al1[e] * sp1;
                    }
                    float* gp = (float*)(ws + WS_GT) + (size_t)row * 32 + 8 * fq;
                    *(f32x4*)gp = o0; *(f32x4*)(gp + 4) = o1;
                    asm volatile("" ::: "memory");
                }
            return;
        }
        bf16_t* dst; int ld; const PG8_LAS float* gain = nullptr; bool rope = false, dosilu = false; float sc = 1.f;
        if (hs < 4)       { dst = (bf16_t*)(ws + WS_QO) + 64 * hs;              ld = 1024; gain = pb + PB_AQN; rope = true; sc = ATT_C2; }
        else if (hs < 6)  { dst = (bf16_t*)(ws + WS_KA) + 64 * (hs - 4);        ld = 128;  gain = pb + PB_AKN; rope = true; }
        else if (hs < 8)  { dst = (bf16_t*)(ws + WS_VA) + 64 * (hs - 6);        ld = 128; }
        else if (hs < 14) { dst = (bf16_t*)(ws + WS_QO) + 256 + 64 * (hs - 8);  ld = 1024; gain = pb + PB_BQN; sc = ATT_C2; }
        else if (hs < 20) { dst = (bf16_t*)(ws + WS_KB) + 64 * (hs - 14);       ld = 384;  gain = pb + PB_BKN; }
        else if (hs < 26) { dst = (bf16_t*)(ws + WS_VB) + 64 * (hs - 20);       ld = 384; }
        else if (hs < 44) { dst = (bf16_t*)(ws + WS_CR) + 64 * (hs - 26);       ld = 1152; }
        else              { dst = (bf16_t*)(ws + WS_CZ) + 64 * (hs - 45);       ld = 384;  dosilu = true; }
        const auto drs = __builtin_amdgcn_make_buffer_rsrc((void*)dst, 0, 0x7fffffff, 0x00020000);
        float g0[8], g1[8];
#pragma unroll
        for (int j = 0; j < 8; ++j) { g0[j] = gain ? gain[8 * fq + j] * sc : sc; g1[j] = gain ? gain[32 + 8 * fq + j] * sc : sc; }
        float inv[8];
#pragma unroll
        for (int j = 0; j < 8; ++j) inv[j] = rope ? __builtin_amdgcn_exp2f(-(float)(8 * (fq & 1) + j) * (13.287712379549449f / 16.0f)) : 0.f;
#pragma unroll
        for (int ai = 0; ai < 2; ++ai) {
            float rs[4];
#pragma unroll
            for (int m = 0; m < 4; ++m) rs[m] = rstd_of(lds, ssq, tbl != 0, ui, ai * HALF + wr * 64 + m * 16 + fr, u.pm * BM + ai * HALF + wr * 64 + m * 16 + fr, fq);
#pragma unroll
            for (int m = 0; m < 4; ++m) {
                const int row = u.pm * BM + ai * HALF + wr * 64 + m * 16 + fr;
                const float r = rs[m];
                float v0[8], v1[8];
#pragma unroll
                for (int j = 0; j < 8; ++j) { v0[j] = acc[ai][0][m][j >> 2][j & 3] * r; v1[j] = acc[ai][1][m][j >> 2][j & 3] * r; }
                float rn = 1.f;
                if (gain) {
                    float ss = 0.f;
#pragma unroll
                    for (int j = 0; j < 8; ++j) ss += v0[j] * v0[j] + v1[j] * v1[j];
                    ss += __shfl_xor(ss, 16); ss += __shfl_xor(ss, 32);
                    rn = __builtin_amdgcn_rsqf(ss * (1.0f / 64.0f) + RMS_EPS);
                }
#pragma unroll
                for (int j = 0; j < 8; ++j) { v0[j] *= rn * g0[j]; v1[j] *= rn * g1[j]; }
                if (rope) {
                    const int t = row & 2047; const float pos = (float)((fq < 2) ? (t >> 6) : (t & 63));
#pragma unroll
                    for (int j = 0; j < 8; ++j) { const float ang = pos * inv[j];
                        const float c = __cosf(ang), s = __sinf(ang); const float x1 = v0[j], x2 = v1[j]; v0[j] = x1 * c - x2 * s; v1[j] = x1 * s + x2 * c; }
                }
                if (dosilu) {
#pragma unroll
                    for (int j = 0; j < 8; ++j) { v0[j] = silu_f(v0[j]); v1[j] = silu_f(v1[j]); }
                }
                const unsigned po = (unsigned)(row * ld + 8 * fq) * 2u;
                u32x4 w; w.x = cvt_pk_bf16(v0[0], v0[1]); w.y = cvt_pk_bf16(v0[2], v0[3]); w.z = cvt_pk_bf16(v0[4], v0[5]); w.w = cvt_pk_bf16(v0[6], v0[7]);
                if (st_en) __builtin_amdgcn_raw_buffer_store_b128(w, drs, po, 0, 16); else asm volatile("" :: "v"(w));
                w.x = cvt_pk_bf16(v1[0], v1[1]); w.y = cvt_pk_bf16(v1[2], v1[3]); w.z = cvt_pk_bf16(v1[4], v1[5]); w.w = cvt_pk_bf16(v1[6], v1[7]);
                if (st_en) __builtin_amdgcn_raw_buffer_store_b128(w, drs, po + 64u, 0, 16); else asm volatile("" :: "v"(w));
                asm volatile("" ::: "memory");
            }
        }
    }
};
template <class Epi, class Sched, bool ALIGN_EPI = false, bool SP2 = false, bool HALFCAP = false>
__device__ __forceinline__ void gemm_phase(PG8_LAS unsigned char* lds, const Gemm g, const Sched& S, const Epi& E, int tid_) {
    asm volatile("" : "+v"(tid_)); const int tid = tid_, wid = __builtin_amdgcn_readfirstlane(tid >> 6), lane = tid & 63, wr = wid >> 2, wc = wid & 3, fr = lane & 15, fq = lane >> 4;
    const int K = g.K, nt = K / BK;
    unsigned voffA[2], voffB[2];
#pragma unroll
    for (int i = 0; i < 2; ++i) { int R, C; stage_rc(tid * 16 + i * 8192, R, C); const int Rb = Epi::PERM ? ((R & ~31) + perm32(R & 31)) : R;
        voffA[i] = (unsigned)(R * K + C) * 2u; voffB[i] = (unsigned)(Rb * K + C) * 2u; }
    const size_t kstep = (size_t)(BK * 2);
    const size_t hstep = (size_t)HALF * K * 2;
    const size_t tstep = 2 * hstep;
    const unsigned ldsw = (unsigned)wid * 1024u;
    int aoff = lds_byte(wr * 64 + fr, fq * 8); const int boff = lds_byte(wc * 32 + fr, fq * 8);
#define PG8_SA(b, h) (((b) * 2 + (h)) * HTB)
#define PG8_SB(b, h) ((4 + (b) * 2 + (h)) * HTB)
#define PG8_STAGE(bufoff, gbase, voff) do { _Pragma("unroll") for (int _i = 0; _i < 2; ++_i) \
        __builtin_amdgcn_global_load_lds((const unsigned*)((const char*)(gbase) + (voff)[_i]), (PG8_LAS unsigned*)(lds + (bufoff) + ldsw + _i * 8192), 16, 0, 0); } while (0)
#define PG8_STAGEA(bufoff, gbase) do { _Pragma("unroll") for (int _i = 0; _i < NPA; ++_i) \
        __builtin_amdgcn_global_load_lds((const unsigned*)((const char*)(gbase) + voffA[_i]), (PG8_LAS unsigned*)(lds + (bufoff) + ldsw + _i * 8192), 16, 0, 0); } while (0)
#define PG8_STAGEA_N(bufoff, gbase, trc) do { _Pragma("unroll") for (int _i = 0; _i < 2; ++_i) if (_i < NPA || (trc)) \
        __builtin_amdgcn_global_load_lds((const unsigned*)((const char*)(gbase) + voffA[_i]), (PG8_LAS unsigned*)(lds + (bufoff) + ldsw + _i * 8192), 16, 0, 0); } while (0)
#define PG8_WAIT_SEL(trc, a, b) do { if (trc) PG8_WAIT_V(a); else PG8_WAIT_V(b); } while (0)
#define PG8_LDA(dst, b, h) do { _Pragma("unroll") for (int m = 0; m < MFR; ++m) _Pragma("unroll") for (int k = 0; k < 2; ++k) dst[m][k] = *(const PG8_LAS bf16x8*)(lds + PG8_SA(b, h) + aoff + m * 2048 + k * 1024); } while (0)
#define PG8_LDB(dst, b, h) do { _Pragma("unroll") for (int n = 0; n < 2; ++n) _Pragma("unroll") for (int k = 0; k < 2; ++k) dst[n][k] = *(const PG8_LAS bf16x8*)(lds + PG8_SB(b, h) + boff + n * 2048 + k * 1024); } while (0)
#define PG8_MMA(ai, bj, At, Bt) do { __builtin_amdgcn_s_setprio(1); _Pragma("unroll") for (int m = 0; m < MFR; ++m) _Pragma("unroll") for (int n = 0; n < 2; ++n) _Pragma("unroll") for (int k = 0; k < 2; ++k) \
        acc[ai][bj][m][n] = __builtin_amdgcn_mfma_f32_16x16x32_bf16(Bt[n][k], At[m][k], acc[ai][bj][m][n], 0, 0, 0); __builtin_amdgcn_s_setprio(0); } while (0)
#define PG8_WAIT_V(n) asm volatile("s_waitcnt vmcnt(" #n ")" ::: "memory")
#define PG8_WAIT_L(n) asm volatile("s_waitcnt lgkmcnt(" #n ")" ::: "memory")
#define PG8_BAR __builtin_amdgcn_s_barrier()
#define PG8_SCHED __builtin_amdgcn_sched_barrier(0)
    Unit cur, nxt; int ui = 0;
    if (!S.next(0, cur)) return;
    static_assert(!HALFCAP || SP2, "half units: SP2 loop only");
    f32x4 acc[2][2][4][2];
#pragma unroll
    for (int a = 0; a < 2; ++a)
#pragma unroll
        for (int b = 0; b < 2; ++b)
#pragma unroll
            for (int m = 0; m < 4; ++m)
#pragma unroll
                for (int n = 0; n < 2; ++n) acc[a][b][m][n] = (f32x4){0.f, 0.f, 0.f, 0.f};
    bf16x8 At[4][2], B0[2][2], B1[2][2];
    const char* cA = (const char*)g.A + (size_t)cur.pm * tstep; const char* cB = (const char*)g.Bt + (size_t)cur.pn * tstep;
    size_t ahs = hstep;
    if constexpr (HALFCAP) { if (cur.hm) { if (cur.hm == 2) cA += hstep; ahs = hstep >> 1; aoff = lds_byte(wr * 32 + fr, fq * 8); } }
    S.a_ready(cur);
    {   constexpr int NPA = 2;
    if constexpr (SP2) {
        PG8_STAGE(PG8_SB(0, 0), cB, voffB); PG8_STAGE(PG8_SB(0, 1), cB + hstep, voffB); PG8_STAGEA(PG8_SA(0, 0), cA); PG8_STAGEA(PG8_SA(0, 1), cA + ahs);
        if (wr == 1) PG8_BAR;
        PG8_WAIT_V(2); PG8_BAR;
        PG8_STAGE(PG8_SB(1, 0), cB + kstep, voffB); PG8_STAGEA(PG8_SA(1, 0), cA + kstep); PG8_STAGE(PG8_SB(1, 1), cB + hstep + kstep, voffB);
        PG8_WAIT_V(6); PG8_BAR;
    } else {
        PG8_STAGE(PG8_SB(0, 0), cB, voffB); PG8_STAGE(PG8_SA(0, 0), cA, voffA); PG8_STAGE(PG8_SB(0, 1), cB + hstep, voffB); PG8_STAGE(PG8_SA(0, 1), cA + hstep, voffA);
        if (wr == 1) PG8_BAR;
        PG8_WAIT_V(4); PG8_BAR;
        PG8_STAGE(PG8_SB(1, 0), cB + kstep, voffB); PG8_STAGE(PG8_SA(1, 0), cA + kstep, voffA); PG8_STAGE(PG8_SB(1, 1), cB + hstep + kstep, voffB);
        PG8_WAIT_V(6); PG8_BAR;
    }
    }
#define PG8_KLOOP(WV, TRX) \
        for (int t = 0; t < nt; t += 2) { \
            const bool last = (t == nt - 2); \
            const bool trc = last && (TRX);            \
            const char* a1 = cA + (size_t)(t + 1) * kstep; \
            const char* a2 = last ? nA : cA + (size_t)(t + 2) * kstep; const char* b2 = last ? nB : cB + (size_t)(t + 2) * kstep; \
            const char* a3 = a2 + kstep; const char* b3 = b2 + kstep; \
            const size_t ah2 = last ? nahs : ahs; \
            if (last && has_next) S.a_ready(nxt); \
            PG8_LDB(B0, 0, 0); PG8_LDB(B1, 0, 1); PG8_SCHED; PG8_LDA(At, 0, 0); PG8_STAGEA(PG8_SA(1, 1), a1 + ahs); \
            PG8_WAIT_V(WV); PG8_WAIT_L(0); PG8_BAR; PG8_MMA(0, 0, At, B0); PG8_MMA(0, 1, At, B1); PG8_BAR; PG8_SCHED; \
            PG8_LDA(At, 0, 1); PG8_STAGE(PG8_SB(0, 0), b2, voffB); PG8_STAGE(PG8_SB(0, 1), b2 + hstep, voffB); PG8_STAGEA_N(PG8_SA(0, 0), a2, trc); \
            PG8_WAIT_SEL(trc, 7, WV); PG8_WAIT_L(0); PG8_BAR; PG8_MMA(1, 0, At, B0); PG8_MMA(1, 1, At, B1); PG8_BAR; PG8_SCHED; \
            PG8_LDB(B0, 1, 0); PG8_LDB(B1, 1, 1); PG8_SCHED; PG8_LDA(At, 1, 0); PG8_STAGEA_N(PG8_SA(0, 1), a2 + ah2, trc); \
            PG8_WAIT_SEL(trc, 8, WV); PG8_WAIT_L(0); PG8_BAR; PG8_MMA(0, 0, At, B0); PG8_MMA(0, 1, At, B1); PG8_BAR; PG8_SCHED; \
            PG8_LDA(At, 1, 1); PG8_STAGE(PG8_SB(1, 0), b3, voffB); PG8_STAGE(PG8_SB(1, 1), b3 + hstep, voffB); PG8_STAGEA_N(PG8_SA(1, 0), a3, trc); \
            PG8_WAIT_SEL(trc, 8, WV); PG8_WAIT_L(0); PG8_BAR; PG8_MMA(1, 0, At, B0); PG8_MMA(1, 1, At, B1); PG8_BAR; PG8_SCHED; \
        }
    for (;;) {
        const bool has_next = S.next(ui + 1, nxt);
        const char* nA = has_next ? (const char*)g.A + (size_t)nxt.pm * tstep : cA; const char* nB = has_next ? (const char*)g.Bt + (size_t)nxt.pn * tstep : cB;
        size_t nahs = has_next ? hstep : ahs;
        if constexpr (HALFCAP) { if (has_next && nxt.hm) { if (nxt.hm == 2) nA += hstep; nahs = hstep >> 1; } }
        if constexpr (SP2) {
            if constexpr (HALFCAP) {
                if (cur.hm) { constexpr int MFR = 2, NPA = 1; const bool nfull = has_next && !nxt.hm; PG8_KLOOP(6, nfull) }
                else { constexpr int MFR = 4, NPA = 2; PG8_KLOOP(8, false) }
            } else { constexpr int MFR = 4, NPA = 2; PG8_KLOOP(8, false) }
        } else {
        constexpr int MFR = 4;
        for (int t = 0; t < nt; t += 2) {
            const bool last = (t == nt - 2);
            const char* a1 = cA + (size_t)(t + 1) * kstep;
            const char* a2 = last ? nA : cA + (size_t)(t + 2) * kstep; const char* b2 = last ? nB : cB + (size_t)(t + 2) * kstep;
            const char* a3 = a2 + kstep; const char* b3 = b2 + kstep;
            if (last && has_next) S.a_ready(nxt);
            PG8_LDB(B0, 0, 0); PG8_SCHED; PG8_LDA(At, 0, 0); PG8_STAGE(PG8_SA(1, 1), a1 + hstep, voffA);
            PG8_WAIT_L(8); PG8_BAR; PG8_WAIT_L(0); PG8_MMA(0, 0, At, B0); PG8_BAR; PG8_SCHED;
            PG8_LDB(B1, 0, 1); PG8_STAGE(PG8_SB(0, 0), b2, voffB);
            PG8_BAR; PG8_WAIT_L(0); PG8_MMA(0, 1, At, B1); PG8_BAR;
            PG8_LDA(At, 0, 1); PG8_STAGE(PG8_SA(0, 0), a2, voffA);
            PG8_BAR; PG8_WAIT_L(0); PG8_MMA(1, 0, At, B0); PG8_BAR; PG8_SCHED;
            PG8_STAGE(PG8_SB(0, 1), b2 + hstep, voffB);
            PG8_WAIT_V(6); PG8_BAR; PG8_MMA(1, 1, At, B1); PG8_BAR;
            PG8_LDB(B0, 1, 0); PG8_SCHED; PG8_LDA(At, 1, 0); PG8_STAGE(PG8_SA(0, 1), a2 + hstep, voffA);
            PG8_WAIT_L(8); PG8_BAR; PG8_WAIT_L(0); PG8_MMA(0, 0, At, B0); PG8_BAR; PG8_SCHED;
            PG8_LDB(B1, 1, 1); PG8_STAGE(PG8_SB(1, 0), b3, voffB);
            PG8_BAR; PG8_WAIT_L(0); PG8_MMA(0, 1, At, B1); PG8_BAR;
            PG8_LDA(At, 1, 1); PG8_STAGE(PG8_SA(1, 0), a3, voffA);
            PG8_BAR; PG8_WAIT_L(0); PG8_MMA(1, 0, At, B0); PG8_BAR; PG8_SCHED;
            PG8_STAGE(PG8_SB(1, 1), b3 + hstep, voffB);
            PG8_WAIT_V(6); PG8_BAR; PG8_MMA(1, 1, At, B1); PG8_BAR;
        }
        }
        if constexpr (ALIGN_EPI) { if (wr == 0) PG8_BAR; }
        if constexpr (!Epi::AFTER_DRAIN) { _Pragma("unroll 1") for (int dp_ = 0; dp_ <= Epi::DUPN; ++dp_) { const int le_ = pg8_lane_id(); E(acc, cur, wr, wc, le_ & 15, le_ >> 4, ui | (dp_ << 16), lds); } S.done(cur); }
        if (!has_next) break;
#pragma unroll
        for (int a = 0; a < 2; ++a)
#pragma unroll
            for (int b = 0; b < 2; ++b)
#pragma unroll
                for (int m = 0; m < 4; ++m)
#pragma unroll
                    for (int n = 0; n < 2; ++n) acc[a][b][m][n] = (f32x4){0.f, 0.f, 0.f, 0.f};
        cur = nxt; cA = nA; cB = nB; ahs = nahs; ++ui;
        if constexpr (HALFCAP) { const int le_ = pg8_lane_id(); aoff = lds_byte((cur.hm ? wr * 32 : wr * 64) + (le_ & 15), (le_ >> 4) * 8); }
        if constexpr (ALIGN_EPI) { if (wr == 1) PG8_BAR; }
    }
    PG8_WAIT_V(0);
    if constexpr (!ALIGN_EPI) { if (wr == 0) PG8_BAR; }
    PG8_BAR;
    if constexpr (Epi::AFTER_DRAIN) { E.fused(acc, cur, wr, wc, fr, fq, lds, wid, lane); S.done(cur); }
#undef PG8_SA
#undef PG8_SB
#undef PG8_STAGE
#undef PG8_LDA
#undef PG8_STAGEA
#undef PG8_STAGEA_N
#undef PG8_WAIT_SEL
#undef PG8_KLOOP
#undef PG8_LDB
#undef PG8_MMA
#undef PG8_WAIT_V
#undef PG8_WAIT_L
#undef PG8_BAR
#undef PG8_SCHED
}
}

__device__ __forceinline__ unsigned f2bf(float f) { unsigned u = __builtin_bit_cast(unsigned, f); return (u + 0x7fffu + ((u >> 16) & 1u)) >> 16; }
__device__ __forceinline__ unsigned pk2(float lo, float hi) { return f2bf(lo) | (f2bf(hi) << 16); }
__device__ __forceinline__ float bf2f(bf16 b) { return __builtin_bit_cast(float, (unsigned)b << 16); }
__device__ __forceinline__ float wave_sum(float v) {
#pragma unroll
    for (int o = 1; o < 64; o <<= 1) v += __shfl_xor(v, o);
    return v;
}

__device__ __forceinline__ int t5_bucket_dev(int rel) {
    const int n = rel < 0 ? -rel : rel; const int sign = rel > 0 ? 16 : 0;
    const float nf = (float)(n > 1 ? n : 1);
    int large = 8 + (int)(logf(nf / 8.0f) / 4.852030263919617f * 8.0f);
    large = large < 15 ? large : 15;
    return sign + (n < 8 ? n : large);
}

struct MKArgs { const float* in[21]; float* out; unsigned char* ws; int ph_lo, ph_hi; };
typedef MKArgs ProArgs;
__device__ __forceinline__ void cvt_item(const float* W, int ldw, int c0, int nvalid, const float* gain, bf16* dst0, int K, int k0, LAS float* scr, int lane) {
    if (nvalid == 32) {
        const int kr = lane >> 3, c4 = (lane & 7) * 4;
        f32x4 v[8];
#pragma unroll
        for (int i = 0; i < 8; ++i) v[i] = *(const f32x4*)(W + (size_t)(k0 + 8 * i + kr) * ldw + c0 + c4);
#pragma unroll
        for (int i = 0; i < 8; ++i) { const int kk = 8 * i + kr; const float gsc = gain ? gain[k0 + kk] : 1.0f;
            scr[kk * 33 + c4] = v[i][0] * gsc; scr[kk * 33 + c4 + 1] = v[i][1] * gsc; scr[kk * 33 + c4 + 2] = v[i][2] * gsc; scr[kk * 33 + c4 + 3] = v[i][3] * gsc; }
    } else {
#pragma unroll 8
        for (int i = 0; i < 32; ++i) { const int kk = 2 * i + (lane >> 5), j = lane & 31;
            float v = (j < nvalid) ? W[(size_t)(k0 + kk) * ldw + c0 + j] : 0.f; if (gain) v *= gain[k0 + kk];
            scr[kk * 33 + j] = v; }
    }
    asm volatile("s_waitcnt lgkmcnt(0)" ::: "memory");
    const int c = lane & 7;
#pragma unroll
    for (int jj = 0; jj < 4; ++jj) { const int n = (lane >> 3) + 8 * jj; const LAS float* s = scr + (8 * c) * 33 + pg8::perm32(n);
        v4u o; o.x = pk2(s[0 * 33], s[1 * 33]); o.y = pk2(s[2 * 33], s[3 * 33]); o.z = pk2(s[4 * 33], s[5 * 33]); o.w = pk2(s[6 * 33], s[7 * 33]);
        *(v4u*)(dst0 + (size_t)n * K + k0 + 8 * c) = o; }
    asm volatile("s_waitcnt lgkmcnt(0)" ::: "memory");
}
constexpr int IT_GU = (NGU / 32) * (DM / 64), IT_D = (DM / 32) * (DFF / 64), IT_IN = (NINP / 32) * (DM / 64), IT_O = (DM / 32) * (DM / 64);
constexpr int IT_LAYER = 2 * IT_GU + 2 * IT_D + IT_IN + IT_O;
typedef const float* cfp;
#define CAS __attribute__((address_space(4)))
struct CvtD { const float* W; const float* gain; bf16* dst0; int ldw, c0, nvalid, K, k0; };
__device__ __forceinline__ CvtD cvt_decode(const CAS cfp* inp, unsigned char* ws, int it) {
    CvtD d;
    const int l = it / IT_LAYER; int r = it % IT_LAYER;
    unsigned char* wl = ws + WS_W + (size_t)l * W_LAYER;
    if (r < 2 * IT_GU) {
        const int f = r / IT_GU; r %= IT_GU;
        const float* Wg = inp[f ? 18 : 3] + (size_t)l * DM * DFF; const float* Wu = inp[f ? 19 : 4] + (size_t)l * DM * DFF;
        const int ng = NGU / 32, kb = r / ng, g = r % ng, pn = g >> 3, bj = (g >> 2) & 1, wc = g & 3;
        d.W = bj ? Wu : Wg; d.ldw = DFF; d.c0 = 128 * pn + 32 * wc; d.nvalid = 32; d.gain = inp[f ? 17 : 2] + (size_t)l * DM; d.dst0 = (bf16*)(wl + (f ? OFF_GU2 : OFF_GU1)) + (size_t)(32 * g) * DM; d.K = DM; d.k0 = 64 * kb;
        return d;
    }
    r -= 2 * IT_GU;
    if (r < 2 * IT_D) {
        const int f = r / IT_D; r %= IT_D;
        const int ng = DM / 32, kb = r / ng, g = r % ng;
        d.W = inp[f ? 20 : 5] + (size_t)l * DFF * DM; d.ldw = DM; d.c0 = 32 * g; d.nvalid = 32; d.gain = nullptr; d.dst0 = (bf16*)(wl + (f ? OFF_D2 : OFF_D1)) + (size_t)(32 * g) * DFF; d.K = DFF; d.k0 = 64 * kb;
        return d;
    }
    r -= 2 * IT_D;
    if (r < IT_IN) {
        const int ng = NINP / 32, kb = r / ng, g = r % ng, pn = g >> 3, bj = (g >> 2) & 1, wc = g & 3, v = 4 * pn + wc;
        const int c0 = (v < 44 ? 64 * v : (v == 44 ? 3200 : (v < 51 ? 2816 + 64 * (v - 45) : NIN))) + 32 * bj;
        int nv = (v == 44 ? 3224 : (v < 51 ? 1 << 30 : 0)) - c0; nv = nv < 0 ? 0 : (nv > 32 ? 32 : nv);
        d.W = inp[7] + (size_t)l * DM * NIN; d.ldw = NIN; d.c0 = nv > 0 ? c0 : 0; d.nvalid = nv; d.gain = inp[6] + (size_t)l * DM; d.dst0 = (bf16*)(wl + OFF_IN) + (size_t)(32 * g) * DM; d.K = DM; d.k0 = 64 * kb;
        return d;
    }
    r -= IT_IN;
    {   const int ng = DM / 32, kb = r / ng, g = r % ng;
        d.W = inp[16] + (size_t)l * DM * DM; d.ldw = DM; d.c0 = 32 * g; d.nvalid = 32; d.gain = nullptr; d.dst0 = (bf16*)(wl + OFF_O) + (size_t)(32 * g) * DM; d.K = DM; d.k0 = 64 * kb; }
    return d;
}
__device__ __forceinline__ void cvt_out(const CvtD& d, LAS float* scr, int lane) {
    const int c = lane & 7;
#pragma unroll
    for (int jj = 0; jj < 4; ++jj) { const int n = (lane >> 3) + 8 * jj; const LAS float* s = scr + (8 * c) * 33 + pg8::perm32(n);
        v4u o; o.x = pk2(s[0 * 33], s[1 * 33]); o.y = pk2(s[2 * 33], s[3 * 33]); o.z = pk2(s[4 * 33], s[5 * 33]); o.w = pk2(s[6 * 33], s[7 * 33]);
        *(v4u*)(d.dst0 + (size_t)n * d.K + d.k0 + 8 * c) = o; }
}
__device__ __forceinline__ void cvt_pair(const CvtD& a, const CvtD& b, LAS float* scr, int lane) {
    const int kr = lane >> 3, c4 = (lane & 7) * 4; LAS float* sb = scr + 64 * 33;
    f32x4 va[8], vb[8];
#pragma unroll
    for (int i = 0; i < 8; ++i) va[i] = *(const f32x4*)(a.W + (size_t)(a.k0 + 8 * i + kr) * a.ldw + a.c0 + c4);
#pragma unroll
    for (int i = 0; i < 8; ++i) vb[i] = *(const f32x4*)(b.W + (size_t)(b.k0 + 8 * i + kr) * b.ldw + b.c0 + c4);
#pragma unroll
    for (int i = 0; i < 8; ++i) { const int kk = 8 * i + kr; const float ga = a.gain ? a.gain[a.k0 + kk] : 1.0f, gb = b.gain ? b.gain[b.k0 + kk] : 1.0f;
        scr[kk * 33 + c4] = va[i][0] * ga; scr[kk * 33 + c4 + 1] = va[i][1] * ga; scr[kk * 33 + c4 + 2] = va[i][2] * ga; scr[kk * 33 + c4 + 3] = va[i][3] * ga;
        sb[kk * 33 + c4] = vb[i][0] * gb; sb[kk * 33 + c4 + 1] = vb[i][1] * gb; sb[kk * 33 + c4 + 2] = vb[i][2] * gb; sb[kk * 33 + c4 + 3] = vb[i][3] * gb; }
    asm volatile("s_waitcnt lgkmcnt(0)" ::: "memory");
    cvt_out(a, scr, lane); cvt_out(b, sb, lane);
    asm volatile("s_waitcnt lgkmcnt(0)" ::: "memory");
}
constexpr int CVT_WAVE_LDS = 2 * 64 * 33 * 4;
__device__ __forceinline__ void convert_weights(const CAS cfp* inp, unsigned char* ws, LAS unsigned char* lds, int gw, int NGW, int wave, int lane, int part) {
    LAS float* scr = (LAS float*)(lds + wave * CVT_WAVE_LDS);
    bool have = false; CvtD pend;
#pragma unroll 1
    for (int it = gw; it < DEPTH * IT_LAYER; it += NGW) {
        const int l = it / IT_LAYER, r = it % IT_LAYER;
        const bool early = (l == 0) && (r < IT_GU || (r >= 2 * IT_GU && r < 2 * IT_GU + IT_D) || (r >= 2 * IT_GU + 2 * IT_D && r < 2 * IT_GU + 2 * IT_D + IT_IN));
        if (early != (part == 0)) continue;
        const CvtD d = cvt_decode(inp, ws, it);
        if (d.nvalid != 32) { cvt_item(d.W, d.ldw, d.c0, d.nvalid, d.gain, d.dst0, d.K, d.k0, scr, lane); continue; }
        if (have) { cvt_pair(pend, d, scr, lane); have = false; } else { pend = d; have = true; }
    }
    if (have) cvt_item(pend.W, pend.ldw, pend.c0, pend.nvalid, pend.gain, pend.dst0, pend.K, pend.k0, scr, lane);
}
__device__ __forceinline__ void prologue_phase(const CAS cfp* inp, unsigned char* ws, LAS unsigned char* lds, int gw, int NGW, int wave, int lane) {
    convert_weights(inp, ws, lds, gw, NGW, wave, lane, 0);
    {
        float* pb = (float*)(ws + WS_PB);
        for (int i = gw * 64 + lane; i < PB_FLOATS; i += NGW * 64) {
            float v = 0.f;
            if (i >= PB_TB) { const int k = i - PB_TB, hb = k / 136, idx = k % 136, h = hb / 3, br = hb % 3, dil = br == 0 ? 1 : (br == 1 ? 4 : 16);
                v = idx <= 128 ? inp[1][t5_bucket_dev((idx - 64) * dil) * 6 + h] * 1.4426950408889634f : 0.f; }
            else if (i >= PB_REL) v = inp[1][i - PB_REL];
            else { const int l = i / PB_LAYER, r = i % PB_LAYER;
                if (r < 64) v = inp[8][l * 64 + r]; else if (r < 128) v = inp[9][l * 64 + r - 64]; else if (r < 192) v = inp[10][l * 64 + r - 128]; else if (r < 256) v = inp[11][l * 64 + r - 192];
                else if (r < 320) v = inp[15][l * 64 + r - 256]; else if (r < 332) v = inp[13][l * 12 + r - 320]; else if (r < 344) v = inp[14][l * 12 + r - 332];
                else if (r == PB_REFA || r == PB_REFB) {
                    const float* gq = inp[r == PB_REFA ? 8 : 10] + l * 64; const float* gk = inp[r == PB_REFA ? 9 : 11] + l * 64; float mq = 0.f, mk = 0.f, mb = 0.f;
                    for (int e = 0; e < 64; ++e) { mq = fmaxf(mq, fabsf(gq[e])); mk = fmaxf(mk, fabsf(gk[e])); }
                    if (r == PB_REFB) for (int e = 0; e < 192; ++e) mb = fmaxf(mb, inp[1][e] * 1.4426950408889634f);
                    v = 0.125f * 1.4426950408889634f * 64.0f * mq * mk + mb; }
                else if (r >= PB_CONV) v = inp[12][(size_t)l * 5760 + r - PB_CONV]; }
            pb[i] = v; }
    }
    const float* x = inp[0]; bf16* hb = (bf16*)(ws + WS_HB); float* ssq = (float*)(ws + WS_SSQ);
#pragma unroll 1
    for (int m0 = gw; m0 < MT; m0 += 4 * NGW) {
        f32x4 v[4][4];
#pragma unroll
        for (int r = 0; r < 4; ++r) { const int m = m0 + r * NGW; const f32x4* xr = (const f32x4*)(x + (size_t)(m < MT ? m : gw) * DM) + lane;
#pragma unroll
            for (int j = 0; j < 4; ++j) v[r][j] = xr[64 * j]; }
#pragma unroll
        for (int r = 0; r < 4; ++r) { const int m = m0 + r * NGW; if (m >= MT) break;
            unsigned long long* o8 = (unsigned long long*)(hb + (size_t)m * DM) + lane;
#pragma unroll
            for (int j = 0; j < 4; ++j) { const f32x4 w = v[r][j];
                o8[64 * j] = (unsigned long long)pk2(w[0], w[1]) | ((unsigned long long)pk2(w[2], w[3]) << 32);
                float s = (w[0] * w[0] + w[1] * w[1]) + (w[2] * w[2] + w[3] * w[3]);
                s += __shfl_xor(s, 1); s += __shfl_xor(s, 2); s += __shfl_xor(s, 4); s += __shfl_xor(s, 8);
                if ((lane & 15) == 0) ssq[(size_t)m * 16 + 4 * j + (lane >> 4)] = s; }
        }
    }
}
namespace att {
typedef short bf16x8 __attribute__((ext_vector_type(8)));
typedef short v4i16 __attribute__((ext_vector_type(4)));
typedef float f32x16 __attribute__((ext_vector_type(16)));
typedef float f32x2_t __attribute__((ext_vector_type(2)));
typedef __bf16 bf16x2_t __attribute__((ext_vector_type(2)));
constexpr int NS = 4, DP = 3;
constexpr int L_K = 0, L_V = NS * 8192, L_WS = 2 * NS * 8192, L_TB = L_WS + 2048, L_OST = L_TB + 18 * 544, L_END = L_OST + 8 * 4096;
__device__ __forceinline__ void ring_wait(int rem) {
    if (rem >= 2) asm volatile("s_waitcnt vmcnt(4)" ::: "memory"); else if (rem == 1) asm volatile("s_waitcnt vmcnt(2)" ::: "memory"); else asm volatile("s_waitcnt vmcnt(0)" ::: "memory");
    __builtin_amdgcn_s_barrier(); asm volatile("" ::: "memory");
}
__device__ __forceinline__ int crow(int r, int hi) { return (r & 3) + 8 * (r >> 2) + 4 * hi; }
__device__ __forceinline__ unsigned cvtpk(float lo, float hi) { f32x2_t v = {lo, hi}; bf16x2_t b = __builtin_convertvector(v, bf16x2_t); return __builtin_bit_cast(unsigned, b); }
__device__ __forceinline__ v4i16 vtr(const LAS char* p) { return __builtin_amdgcn_ds_read_tr16_b64_v4i16((LAS v4i16*)p); }
__device__ __forceinline__ void stage16(const void* gsrc, LAS unsigned char* dst_wave_uniform) { unsigned keep; const unsigned d = (unsigned)__builtin_amdgcn_readfirstlane((int)(unsigned)(uintptr_t)dst_wave_uniform);
    asm volatile("s_mov_b32 %0, m0\n\ts_mov_b32 m0, %2\n\ts_nop 0\n\tglobal_load_lds_dwordx4 %1, off\n\ts_mov_b32 m0, %0" : "=&s"(keep) : "v"(gsrc), "s"(d) : "memory"); }

template <int MODE>
__device__ __forceinline__ void tile_compute(const LAS char* Kb, const LAS char* Vb, const bf16x8 (&qf)[4], f32x16 (&o)[2], float& lsum, float negref, int r32, int hi, int lane,
                                             int ik0, int iq, int L, const LAS float* tb) {
    f32x16 p0, p1;
#pragma unroll
    for (int r = 0; r < 16; ++r) { p0[r] = negref; p1[r] = negref; }
    const LAS char* kp = Kb + hi * 1024 + r32 * 16;
    bf16x8 kf0[4], kf1[4];
#pragma unroll
    for (int s = 0; s < 4; ++s) { kf0[s] = *(const LAS bf16x8*)(kp + s * 2048); kf1[s] = *(const LAS bf16x8*)(kp + s * 2048 + 512); }
    __builtin_amdgcn_s_setprio(1);
#pragma unroll
    for (int s = 0; s < 4; ++s) {
        p0 = __builtin_amdgcn_mfma_f32_32x32x16_bf16(kf0[s], qf[s], p0, 0, 0, 0);
        p1 = __builtin_amdgcn_mfma_f32_32x32x16_bf16(kf1[s], qf[s], p1, 0, 0, 0);
    }
    __builtin_amdgcn_s_setprio(0);
    if (MODE == 1) {
        const int d0 = ik0 - iq + 64;
        {   float bb[16];
#pragma unroll
            for (int r = 0; r < 16; ++r) bb[r] = tb[min(max(d0 + crow(r, hi), 0), 128)];
#pragma unroll
            for (int r = 0; r < 16; ++r) { const int x0 = d0 + crow(r, hi); p0[r] = __builtin_amdgcn_exp2f(p0[r] + (((unsigned)x0 <= 128u) ? bb[r] : -1e30f)); }
        }
        {   float bb[16];
#pragma unroll
            for (int r = 0; r < 16; ++r) bb[r] = tb[min(max(d0 + 32 + crow(r, hi), 0), 128)];
#pragma unroll
            for (int r = 0; r < 16; ++r) { const int x1 = d0 + 32 + crow(r, hi); p1[r] = __builtin_amdgcn_exp2f(p1[r] + (((unsigned)x1 <= 128u) ? bb[r] : -1e30f)); }
        }
    } else {
#pragma unroll
        for (int r = 0; r < 16; ++r) { p0[r] = __builtin_amdgcn_exp2f(p0[r]); p1[r] = __builtin_amdgcn_exp2f(p1[r]); }
    }
    float sa = 0.f, sb = 0.f;
#pragma unroll
    for (int r = 0; r < 16; ++r) { sa += p0[r]; sb += p1[r]; }
    lsum += sa + sb;
    bf16x8 pa[4];
#pragma unroll
    for (int ks = 0; ks < 4; ++ks) {
        unsigned w[4];
#pragma unroll
        for (int e = 0; e < 4; ++e) { const int r = 8 * (ks & 1) + 2 * e; w[e] = (ks < 2) ? cvtpk(p0[r], p0[r + 1]) : cvtpk(p1[r], p1[r + 1]); }
        typedef unsigned u32x4_t __attribute__((ext_vector_type(4)));
        const u32x4_t wv = {w[0], w[1], w[2], w[3]};
        pa[ks] = __builtin_bit_cast(bf16x8, wv);
    }
    const LAS char* vp = Vb + ((lane >> 4) & 1) * 32 + (lane & 3) * 8 + (4 * hi + ((lane & 15) >> 2)) * 64;
#pragma unroll
    for (int dh = 0; dh < 2; ++dh) {
        bf16x8 vf[4];
#pragma unroll
        for (int ks = 0; ks < 4; ++ks) { const v4i16 lo = vtr(vp + dh * 4096 + ks * 1024), hh = vtr(vp + dh * 4096 + ks * 1024 + 512); vf[ks] = (bf16x8){lo[0], lo[1], lo[2], lo[3], hh[0], hh[1], hh[2], hh[3]}; }
        __builtin_amdgcn_s_setprio(1);
#pragma unroll
        for (int ks = 0; ks < 4; ++ks) o[dh] = __builtin_amdgcn_mfma_f32_32x32x16_bf16(pa[ks], vf[ks], o[dh], 0, 0, 0);
        __builtin_amdgcn_s_setprio(0);
    }
}

template <class RowPtr> __device__ __forceinline__ void store_tile(LAS unsigned char* stg, const f32x16 (&o)[2], const float (&sc)[16], int r32, int hi, int lane, RowPtr rowptr) {
#pragma unroll
    for (int r = 0; r < 16; ++r) { const int q = crow(r, hi);
        *(LAS unsigned short*)(stg + q * 128 + r32 * 2) = (unsigned short)cvtpk(o[0][r] * sc[r], 0.f); *(LAS unsigned short*)(stg + q * 128 + 64 + r32 * 2) = (unsigned short)cvtpk(o[1][r] * sc[r], 0.f); }
    asm volatile("s_waitcnt lgkmcnt(0)" ::: "memory");
    typedef unsigned u32x4_t __attribute__((ext_vector_type(4)));
#pragma unroll
    for (int i = 0; i < 4; ++i) { const int row = i * 8 + (lane >> 3), ch = lane & 7; const u32x4_t v = *(const LAS u32x4_t*)(stg + row * 128 + ch * 16); *(u32x4_t*)(rowptr(row) + ch * 8) = v; }
}

__device__ __forceinline__ void itemA(LAS unsigned char* lds, int item, int tid, unsigned char* ws, float refA, bf16* Obase, int opitch) {
    const int lane = tid & 63, wave = __builtin_amdgcn_readfirstlane(tid >> 6), r32 = lane & 31, hi = lane >> 5;
    const int qb = item & 7, h = (item >> 3) & 3, b = item >> 5, kvh = h >> 1;
    bf16* QO = (bf16*)(ws + WS_QO); const bf16* KA = (const bf16*)(ws + WS_KA); const bf16* VA = (const bf16*)(ws + WS_VA);
    const size_t rowbase = (size_t)b * SEQ;
    const bf16* ksrc = KA + (rowbase + lane) * 128 + kvh * 64 + wave * 8;
    const bf16* vsrc = VA + (rowbase + 16 * (wave & 3) + (lane >> 2)) * 128 + kvh * 64 + (wave >> 2) * 32 + (lane & 3) * 8;
    LAS unsigned char* kdst = lds + L_K + wave * 1024; LAS unsigned char* vdst = lds + L_V + wave * 1024;
#pragma unroll
    for (int t = 0; t < DP; ++t) { stage16(ksrc + (size_t)t * 64 * 128, kdst + t * 8192); stage16(vsrc + (size_t)t * 64 * 128, vdst + t * 8192); }
    bf16* qrow = QO + (rowbase + qb * 256 + wave * 32 + r32) * 1024 + h * 64;
    bf16x8 qf[4];
#pragma unroll
    for (int s = 0; s < 4; ++s) qf[s] = *(const bf16x8*)(qrow + 16 * s + 8 * hi);
    asm volatile("" : "+v"(qf[0]), "+v"(qf[1]), "+v"(qf[2]), "+v"(qf[3]));
    f32x16 o[2];
#pragma unroll
    for (int r = 0; r < 16; ++r) { o[0][r] = 0.f; o[1][r] = 0.f; }
    float lsum = 0.f; const float negref = -refA;
    constexpr int NT = SEQ / 64;
#pragma unroll 1
    for (int t = 0; t < NT; ++t) {
        ring_wait(NT - 1 - t);
        const int cur = t & (NS - 1), nxt = (t + DP) & (NS - 1);
        if (t + DP < NT) { stage16(ksrc + (size_t)(t + DP) * 64 * 128, kdst + nxt * 8192); stage16(vsrc + (size_t)(t + DP) * 64 * 128, vdst + nxt * 8192); }
        tile_compute<0>((const LAS char*)(lds + L_K + cur * 8192), (const LAS char*)(lds + L_V + cur * 8192), qf, o, lsum, negref, r32, hi, lane, 0, 0, 0, nullptr);
    }
    lsum += __shfl_xor(lsum, 32);
    LAS float* wsf = (LAS float*)(lds + L_WS) + wave * 64;
    if (hi == 0) wsf[r32] = lsum;
    asm volatile("s_waitcnt lgkmcnt(0)" ::: "memory");
    float rl[16];
#pragma unroll
    for (int r = 0; r < 16; ++r) rl[r] = __builtin_amdgcn_rcpf(wsf[crow(r, hi)]);
    { bf16* ob = Obase + (rowbase + qb * 256 + wave * 32) * opitch + h * 64; const int op_ = opitch;
      store_tile(lds + L_OST + wave * 4096, o, rl, r32, hi, lane, [=](int row) { return ob + (size_t)row * op_; }); }
    __syncthreads();
}

__device__ __forceinline__ void fill_tables(LAS unsigned char* lds, const float* tbg, int tid) {
    for (int i = tid; i < 18 * 136; i += 512) ((LAS float*)(lds + L_TB))[i] = tbg[i];
    __syncthreads();
}
__device__ __forceinline__ void itemB(LAS unsigned char* lds, int item, int tid, unsigned char* ws, float refB, bf16* const (&Pb)[3], float* const (&Lb)[3]) {
    const int lane = tid & 63, wave = __builtin_amdgcn_readfirstlane(tid >> 6), r32 = lane & 31, hi = lane >> 5;
    const int br = item < 192 ? 0 : (item < 384 ? 1 : 2), rem = br == 2 ? item - 384 : (br == 1 ? item - 192 : item);
    const int bh = br == 2 ? rem >> 3 : rem >> 2, sub = br == 2 ? rem & 7 : rem & 3, b = bh / 6, h = bh % 6;
    const int dil = br == 0 ? 1 : (br == 1 ? 4 : 16), L = SEQ / dil;
    const int ntiles = br == 2 ? 4 : 10, nblk = br == 2 ? 1 : 2;
    const int I0 = br == 0 ? 512 * sub : 0;
    const int resw = br == 0 ? 0 : (br == 1 ? sub : (2 * sub + (wave >> 2)));
    const int iq0 = br == 2 ? 32 * (wave & 3) : I0 + 32 * wave, jlo = br == 2 ? 2 * (wave >> 2) : (wave >> 1), jcnt = br == 2 ? 2 : 3;
    const bf16* QO = (const bf16*)(ws + WS_QO); const bf16* KB = (const bf16*)(ws + WS_KB); const bf16* VB = (const bf16*)(ws + WS_VB);
    bf16* Pout = Pb[0]; float* Lout = Lb[0]; if (br == 1) { Pout = Pb[1]; Lout = Lb[1]; } else if (br == 2) { Pout = Pb[2]; Lout = Lb[2]; }
    const size_t rowbase = (size_t)b * SEQ;
    const LAS float* tb = (const LAS float*)(lds + L_TB) + (h * 3 + br) * 136;
    LAS unsigned char* kdst = lds + L_K + wave * 1024; LAS unsigned char* vdst = lds + L_V + wave * 1024;
#define STAGE_TILE(j, buf) do { \
        const int res_ = br == 0 ? 0 : (br == 1 ? sub : (2 * sub + ((j) >> 1))); \
        const int ikb_ = br == 2 ? 64 * ((j) & 1) : I0 - 64 + 64 * (j); \
        int ik_ = ikb_ + lane; ik_ = ik_ < 0 ? 0 : (ik_ > L - 1 ? L - 1 : ik_); \
        stage16(KB + (rowbase + res_ + dil * ik_) * 384 + h * 64 + wave * 8, kdst + (buf) * 8192); \
        int iv_ = ikb_ + 16 * (wave & 3) + (lane >> 2); iv_ = iv_ < 0 ? 0 : (iv_ > L - 1 ? L - 1 : iv_); \
        stage16(VB + (rowbase + res_ + dil * iv_) * 384 + h * 64 + (wave >> 2) * 32 + (lane & 3) * 8, vdst + (buf) * 8192); } while (0)
    for (int j = 0; j < DP; ++j) STAGE_TILE(j, j);
    const bf16* qbase = QO + (rowbase + resw + (size_t)dil * (iq0 + r32)) * 1024 + 256 + h * 64 + 8 * hi;
    bf16x8 qf[4], qn[4];
#pragma unroll
    for (int s = 0; s < 4; ++s) { qf[s] = *(const bf16x8*)(qbase + 16 * s); qn[s] = nblk == 2 ? *(const bf16x8*)(qbase + (size_t)dil * 256 * 1024 + 16 * s) : qf[s]; }
    asm volatile("" : "+v"(qf[0]), "+v"(qf[1]), "+v"(qf[2]), "+v"(qf[3]), "+v"(qn[0]), "+v"(qn[1]), "+v"(qn[2]), "+v"(qn[3]));
    f32x16 o[2];
#pragma unroll
    for (int r = 0; r < 16; ++r) { o[0][r] = 0.f; o[1][r] = 0.f; }
    float lsum = 0.f; const float negref = -refB;
    int iqc = iq0, jl = jlo;
    auto flush = [&](int iqb) {
        float ls = lsum + __shfl_xor(lsum, 32);
        if (hi == 0) Lout[(rowbase + resw + (size_t)dil * (iqb + r32)) * 6 + h] = ls;
        float one[16];
#pragma unroll
        for (int r = 0; r < 16; ++r) one[r] = 1.0f;
        bf16* ob = Pout + h * 64; const size_t rb_ = rowbase + resw; const int dil_ = dil;
        store_tile(lds + L_OST + wave * 4096, o, one, r32, hi, lane, [=](int row) { return ob + (rb_ + (size_t)dil_ * (iqb + row)) * 384; });
    };
#pragma unroll 1
    for (int j = 0; j < ntiles; ++j) {
        ring_wait(ntiles - 1 - j);
        const int cur = j & (NS - 1);
        if (j + DP < ntiles) STAGE_TILE(j + DP, (j + DP) & (NS - 1));
        if (nblk == 2 && j == jlo + 3) {
            flush(iq0);
#pragma unroll
            for (int r = 0; r < 16; ++r) { o[0][r] = 0.f; o[1][r] = 0.f; }
            lsum = 0.f; iqc = iq0 + 256; jl = jlo + 4;
#pragma unroll
            for (int s = 0; s < 4; ++s) qf[s] = qn[s];
        }
        const int ikb = br == 2 ? 64 * (j & 1) : I0 - 64 + 64 * j;
        if (j >= jl && j < jl + jcnt && ikb >= 0 && ikb < L) {
            tile_compute<1>((const LAS char*)(lds + L_K + cur * 8192), (const LAS char*)(lds + L_V + cur * 8192), qf, o, lsum, negref, r32, hi, lane, ikb, iqc + r32, L, tb);
        }
    }
    flush(iqc);
    __syncthreads();
#undef STAGE_TILE
}
__device__ __forceinline__ void finalizeB(int gtid, int nthreads, unsigned char* ws, const bf16* P0, const bf16* P1, const bf16* P2, const float* L0, const float* L1, const float* L2) {
    bf16* QO = (bf16*)(ws + WS_QO);
    for (int i = gtid; i < MT * 48; i += nthreads) {
        const int row = i / 48, c8 = i % 48, h = c8 >> 3;
        const float l = L0[(size_t)row * 6 + h] + L1[(size_t)row * 6 + h] + L2[(size_t)row * 6 + h]; const float rl = 1.0f / l;
        const v4u a = *(const v4u*)(P0 + (size_t)row * 384 + c8 * 8), bq = *(const v4u*)(P1 + (size_t)row * 384 + c8 * 8), c = *(const v4u*)(P2 + (size_t)row * 384 + c8 * 8);
        v4u o;
#pragma unroll
        for (int e = 0; e < 4; ++e) {
            const float lo = (bf2f((bf16)(a[e] & 0xffff)) + bf2f((bf16)(bq[e] & 0xffff)) + bf2f((bf16)(c[e] & 0xffff))) * rl;
            const float hi2 = (bf2f((bf16)(a[e] >> 16)) + bf2f((bf16)(bq[e] >> 16)) + bf2f((bf16)(c[e] >> 16))) * rl;
            o[e] = pk2(lo, hi2);
        }
        *(v4u*)(QO + (size_t)row * 1024 + 256 + c8 * 8) = o;
    }
}
}
#ifndef PROBE_STAGE
#define PROBE_STAGE 0
#endif
namespace cdn {
typedef short bf16x8 __attribute__((ext_vector_type(8)));
typedef short bf16x4 __attribute__((ext_vector_type(4)));
typedef short v4i16 __attribute__((ext_vector_type(4)));
typedef float f32x16 __attribute__((ext_vector_type(16)));
typedef float f32x4v __attribute__((ext_vector_type(4)));
typedef unsigned u32x4 __attribute__((ext_vector_type(4)));
constexpr int P = 144;
constexpr int QS = 0, KS = 9216, VS = 18432, AS = 27648, MS = 36864, TS = 46080, TES = 55296, WSS = 64512, MF = 73728, UF = MF + 8192, UP = 272, GC = UF + 64 * UP, BETA = GC + 256, EG = BETA + 256, EGL = EG + 256, LEND = EGL + 256;
static_assert(LEND <= 131072, "LDS");
__device__ __forceinline__ int crow(int r, int hi) { return (r & 3) + 8 * (r >> 2) + 4 * hi; }
__device__ __forceinline__ unsigned cvtpk(float lo, float hi) { typedef float f2 __attribute__((ext_vector_type(2))); typedef __bf16 b2 __attribute__((ext_vector_type(2))); f2 v = {lo, hi}; b2 b = __builtin_convertvector(v, b2); return __builtin_bit_cast(unsigned, b); }
__device__ __forceinline__ bf16x8 pack8(float a0, float a1, float a2, float a3, float a4, float a5, float a6, float a7) { const u32x4 w = {cvtpk(a0, a1), cvtpk(a2, a3), cvtpk(a4, a5), cvtpk(a6, a7)}; return __builtin_bit_cast(bf16x8, w); }
__device__ __forceinline__ v4i16 vtr(const LAS unsigned char* p) { return __builtin_amdgcn_ds_read_tr16_b64_v4i16((LAS v4i16*)p); }
__device__ __forceinline__ bf16x8 cat4(v4i16 a, v4i16 b) { return (bf16x8){a[0], a[1], a[2], a[3], b[0], b[1], b[2], b[3]}; }
__device__ __forceinline__ bf16x8 ld8(const LAS unsigned char* p) { return *(const LAS bf16x8*)p; }
__device__ __forceinline__ bf16x8 ld44(const LAS unsigned char* p0, const LAS unsigned char* p1) { const v4i16 a = *(const LAS v4i16*)p0, b = *(const LAS v4i16*)p1; return cat4(a, b); }
__device__ __forceinline__ void st_bf(LAS unsigned char* p, float v) { *(LAS unsigned short*)p = (unsigned short)cvtpk(v, v); }
__device__ __forceinline__ void st_bf2(LAS unsigned char* p0, LAS unsigned char* p1, float v0, float v1) { const unsigned w = cvtpk(v0, v1); *(LAS unsigned short*)p0 = (unsigned short)w; *(LAS unsigned short*)p1 = (unsigned short)(w >> 16); }
#define MFMA32(a, b, c) __builtin_amdgcn_mfma_f32_32x32x16_bf16((a), (b), (c), 0, 0, 0)
#define MFMA16(a, b, c) __builtin_amdgcn_mfma_f32_16x16x32_bf16((a), (b), (c), 0, 0, 0)

__device__ __forceinline__ void prep_item(int item, int lane, unsigned char* ws, unsigned char* xs, const float* convw) {
    const int blk = item / 18, hs = item % 18, seg = lane >> 3, g8 = lane & 7;
    const int ch = hs * 64 + g8 * 8;
    const int t0 = (blk & 31) * 64 + seg * 8; const size_t rowb = (size_t)(blk >> 5) * SEQ;
    const bf16* CR = (const bf16*)(ws + WS_CR);
    u32x4 raw[12];
#pragma unroll
    for (int k = 0; k < 12; ++k) { const int t = t0 + k - 2; raw[k] = (t >= 0 && t < SEQ) ? *(const u32x4*)(CR + (rowb + t) * 1152 + ch) : (u32x4){0u, 0u, 0u, 0u}; }
    float w[5][8];
#pragma unroll
    for (int tp = 0; tp < 5; ++tp) { const f32x4v a = *(const f32x4v*)(convw + tp * 1152 + ch), b = *(const f32x4v*)(convw + tp * 1152 + ch + 4);
        w[tp][0] = a[0]; w[tp][1] = a[1]; w[tp][2] = a[2]; w[tp][3] = a[3]; w[tp][4] = b[0]; w[tp][5] = b[1]; w[tp][6] = b[2]; w[tp][7] = b[3]; }
    bf16* dst = (bf16*)(hs < 6 ? xs + XS_QN : (hs < 12 ? xs + XS_KN : ws + WS_VC)) + (hs % 6) * 64 + g8 * 8;
#pragma unroll
    for (int k = 0; k < 8; ++k) {
        float acc[8];
#pragma unroll
        for (int e = 0; e < 8; ++e) acc[e] = 0.f;
#pragma unroll
        for (int tp = 0; tp < 5; ++tp) { const u32x4 r = raw[k + tp];
#pragma unroll
            for (int e = 0; e < 4; ++e) { acc[2 * e] += __builtin_bit_cast(float, r[e] << 16) * w[tp][2 * e]; acc[2 * e + 1] += __builtin_bit_cast(float, r[e] & 0xffff0000u) * w[tp][2 * e + 1]; } }
        float ss = 0.f;
#pragma unroll
        for (int e = 0; e < 8; ++e) { acc[e] = acc[e] * __builtin_amdgcn_rcpf(1.0f + __expf(-acc[e])); ss += acc[e] * acc[e]; }
        float sc = 1.f;
        if (hs < 12) { ss += __shfl_xor(ss, 1); ss += __shfl_xor(ss, 2); ss += __shfl_xor(ss, 4); sc = __builtin_amdgcn_rsqf(ss + 1e-6f) * (hs < 6 ? 0.125f : 1.0f); }
        const u32x4 o = {cvtpk(acc[0] * sc, acc[1] * sc), cvtpk(acc[2] * sc, acc[3] * sc), cvtpk(acc[4] * sc, acc[5] * sc), cvtpk(acc[6] * sc, acc[7] * sc)};
        *(u32x4*)(dst + (rowb + t0 + k) * 384) = o;
    }
}

__device__ __forceinline__ void kk_tile(LAS unsigned char* lds, int p, int MF1, int tl, int lane);
constexpr int QS2 = 0, KS2 = 18432, AS2 = 36864, WS2 = 55296, US2 = 73728, UPB = 136, VS2 = US2 + 2 * 64 * UPB, MS1 = VS2 + 18432, TS1 = MS1 + 9216, TES1 = TS1 + 9216,
              GC2 = TES1 + 9216, BETA2 = GC2 + 512, EG2 = BETA2 + 512, EGL2 = EG2 + 512, LEND2 = EGL2 + 512;
static_assert(LEND2 <= 139264, "LDS (scan)");
__device__ __forceinline__ void kk_tile(LAS unsigned char* lds, int p, int MF1, int tl, int lane) {
    const int ti = tl >= 6 ? 3 : (tl >= 3 ? 2 : (tl >= 1 ? 1 : 0)), tj = tl - ti * (ti + 1) / 2, l15 = lane & 15, g = lane >> 4;
    const LAS unsigned char* ap = lds + KS2 + p * 9216 + (16 * ti + l15) * P + 16 * g; const LAS unsigned char* bp = lds + KS2 + p * 9216 + (16 * tj + l15) * P + 16 * g;
    f32x4v acc = (f32x4v){0.f, 0.f, 0.f, 0.f};
    acc = MFMA16(ld8(bp), ld8(ap), acc); acc = MFMA16(ld8(bp + 64), ld8(ap + 64), acc);
    const int i = 16 * ti + l15, j0 = 16 * tj + 4 * g;
    const float gci = *(const LAS float*)(lds + GC2 + p * 256 + 4 * i);
    const f32x4v gcj = *(const LAS f32x4v*)(lds + GC2 + p * 256 + 4 * j0), bj = *(const LAS f32x4v*)(lds + BETA2 + p * 256 + 4 * j0);
    f32x4v v;
#pragma unroll
    for (int e = 0; e < 4; ++e) v[e] = (i > j0 + e) ? acc[e] * __builtin_amdgcn_exp2f(gci - gcj[e]) * bj[e] : 0.f;
    *(LAS unsigned long long*)(lds + MS1 + i * P + 2 * j0) = (unsigned long long)cvtpk(v[0], v[1]) | ((unsigned long long)cvtpk(v[2], v[3]) << 32);
    if (ti == tj) *(LAS f32x4v*)(lds + MF1 + ((ti >> 1) * 1024 + (i & 31) * 32 + (j0 & 31)) * 4) = v;
}
__device__ constexpr int sub_qoff(int r) { int s = 0; for (int q = 1; q < r; ++q) s += (q + 3) / 4; return s; }
__device__ __forceinline__ void scan_item(LAS unsigned char* lds, int item, int tid, unsigned char* ws, unsigned char* xs) {
    const int lane0 = tid & 63, wave = __builtin_amdgcn_readfirstlane(tid >> 6);
    int lane = lane0, r32 = lane & 31, hi = lane >> 5, g = lane >> 4, l15 = lane & 15;
#define CDN_IDS() do { lane = lane0; asm volatile("" : "+v"(lane)); r32 = lane & 31; hi = lane >> 5; g = lane >> 4; l15 = lane & 15; } while (0)
    const int dir = item & 1, bh = item >> 1, b = bh / 6, h = bh % 6;
    const size_t rowbase = (size_t)b * SEQ;
    const bf16* QN = (const bf16*)(xs + XS_QN) + h * 64; const bf16* KN = (const bf16*)(xs + XS_KN) + h * 64; const bf16* VC = (const bf16*)(ws + WS_VC) + h * 64;
    const float* GT = (const float*)(ws + WS_GT);
    bf16* OUT = dir ? ((bf16*)(ws + WS_QO) + 640 + h * 64) : ((bf16*)(ws + WS_CF) + h * 64); const int opitch = dir ? 1024 : 384;
    for (int i = tid; i < 36864 / 16; i += 512) *(LAS u32x4*)(lds + AS2 + i * 16) = (u32x4){0u, 0u, 0u, 0u};
    for (int i = tid; i < 27648 / 16; i += 512) *(LAS u32x4*)(lds + MS1 + i * 16) = (u32x4){0u, 0u, 0u, 0u};
    f32x4v St[4];
#pragma unroll
    for (int t = 0; t < 4; ++t) St[t] = (f32x4v){0.f, 0.f, 0.f, 0.f};
    const int prow = (tid >> 3) & 31, pc16 = tid & 7;
    u32x4 nq0 = {0u, 0u, 0u, 0u}, nq1 = nq0, nk0 = nq0, nk1 = nq0, nv0 = nq0, nv1 = nq0; float ng = 0.f, nb = 0.f;
#define CDN_PREFETCH(n) do { if (wave < 4) { const int c_ = dir ? 31 - (n) : (n); const size_t t0_ = rowbase + 64 * c_ + (dir ? 63 - prow : prow), t1_ = rowbase + 64 * c_ + (dir ? 31 - prow : 32 + prow); \
        nq0 = *(const u32x4*)(QN + t0_ * 384 + pc16 * 8); nk0 = *(const u32x4*)(KN + t0_ * 384 + pc16 * 8); nv0 = *(const u32x4*)(VC + t0_ * 384 + pc16 * 8); \
        nq1 = *(const u32x4*)(QN + t1_ * 384 + pc16 * 8); nk1 = *(const u32x4*)(KN + t1_ * 384 + pc16 * 8); nv1 = *(const u32x4*)(VC + t1_ * 384 + pc16 * 8); \
        if (wave == 3) { const size_t tg_ = rowbase + 64 * c_ + (dir ? 63 - lane0 : lane0); ng = GT[tg_ * 32 + 12 + dir * 6 + h]; nb = GT[tg_ * 32 + dir * 6 + h]; } } } while (0)
#define CDN_STAGE(pp) do { if (wave < 4) { \
        *(LAS u32x4*)(lds + QS2 + (pp) * 9216 + prow * P + pc16 * 16) = nq0; *(LAS u32x4*)(lds + QS2 + (pp) * 9216 + (32 + prow) * P + pc16 * 16) = nq1; \
        *(LAS u32x4*)(lds + KS2 + (pp) * 9216 + prow * P + pc16 * 16) = nk0; *(LAS u32x4*)(lds + KS2 + (pp) * 9216 + (32 + prow) * P + pc16 * 16) = nk1; \
        *(LAS u32x4*)(lds + VS2 + (pp) * 9216 + prow * P + pc16 * 16) = nv0; *(LAS u32x4*)(lds + VS2 + (pp) * 9216 + (32 + prow) * P + pc16 * 16) = nv1; \
        if (wave == 3) { float x = ng; \
            _Pragma("unroll") for (int off = 1; off < 64; off <<= 1) { const float y = __shfl_up(x, off); if (lane0 >= off) x += y; } \
            const float tot = __shfl(x, 63); const float x2 = x * 1.4426950408889634f, t2 = tot * 1.4426950408889634f; \
            *(LAS float*)(lds + GC2 + (pp) * 256 + 4 * lane0) = x2; *(LAS float*)(lds + BETA2 + (pp) * 256 + 4 * lane0) = nb; \
            *(LAS float*)(lds + EG2 + (pp) * 256 + 4 * lane0) = __builtin_amdgcn_exp2f(x2); *(LAS float*)(lds + EGL2 + (pp) * 256 + 4 * lane0) = __builtin_amdgcn_exp2f(t2 - x2); } } } while (0)
    CDN_PREFETCH(0);
    CDN_STAGE(0);
    CDN_PREFETCH(1);
    __syncthreads();
#pragma unroll 1
    for (int it = 0; it <= 32; ++it) {
        const int p = it & 1, q = p ^ 1;
        const int MF1 = US2 + p * 64 * UPB;
        CDN_IDS();
        bf16x8 vs0 = {0, 0, 0, 0, 0, 0, 0, 0}, vs1 = vs0, vb0 = vs0, vb1 = vs0, Sb0 = vs0, Sb1 = vs0;
        if (wave >= 4) {
            if (it < 32) {
                if (wave == 4) { kk_tile(lds, p, MF1, 0, lane); kk_tile(lds, p, MF1, 2, lane); kk_tile(lds, p, MF1, 1, lane); }
                else if (wave == 5) { kk_tile(lds, p, MF1, 5, lane); kk_tile(lds, p, MF1, 9, lane); kk_tile(lds, p, MF1, 8, lane); }
                else if (wave == 6) { kk_tile(lds, p, MF1, 3, lane); kk_tile(lds, p, MF1, 4, lane); }
                else { kk_tile(lds, p, MF1, 6, lane); kk_tile(lds, p, MF1, 7, lane); }
            }
        } else {
#pragma unroll 1
            for (int rp_ = 0; rp_ < (PROBE_STAGE == 6 ? 2 : 1); ++rp_)
            if (it >= 1) {
                const int e = 16 * wave + l15, n = it - 1;
                const LAS unsigned char* Qb = lds + QS2 + q * 9216; const LAS unsigned char* Kb = lds + KS2 + q * 9216; const LAS unsigned char* Ab = lds + AS2 + q * 9216;
                const LAS unsigned char* Wb = lds + WS2 + q * 9216; const LAS unsigned char* Ub = lds + US2 + q * 64 * UPB; const LAS unsigned char* EGb = lds + EG2 + q * 256; const LAS unsigned char* ELb = lds + EGL2 + q * 256;
                Sb0 = pack8(St[0][0], St[0][1], St[0][2], St[0][3], St[1][0], St[1][1], St[1][2], St[1][3]);
                Sb1 = pack8(St[2][0], St[2][1], St[2][2], St[2][3], St[3][0], St[3][1], St[3][2], St[3][3]);
                f32x4v vn[4];
#pragma unroll
                for (int t4 = 0; t4 < 4; ++t4) {
                    const LAS unsigned char* wp = Wb + (4 * g + (l15 >> 2)) * P + (16 * t4 + 4 * (l15 & 3)) * 2;
                    f32x4v acc = (f32x4v){0.f, 0.f, 0.f, 0.f};
                    acc = MFMA16(cat4(vtr(wp), vtr(wp + 16 * P)), Sb0, acc);
                    acc = MFMA16(cat4(vtr(wp + 32 * P), vtr(wp + 48 * P)), Sb1, acc);
                    const unsigned long long uu = *(const LAS unsigned long long*)(Ub + e * UPB + 2 * (16 * t4 + 4 * g));
                    const f32x4v u = {__builtin_bit_cast(float, (unsigned)uu << 16), __builtin_bit_cast(float, (unsigned)uu & 0xffff0000u), __builtin_bit_cast(float, (unsigned)(uu >> 32) << 16), __builtin_bit_cast(float, (unsigned)(uu >> 32) & 0xffff0000u)};
                    vn[t4] = u - acc;
                }
                vb0 = pack8(vn[0][0], vn[0][1], vn[0][2], vn[0][3], vn[1][0], vn[1][1], vn[1][2], vn[1][3]);
                vb1 = pack8(vn[2][0], vn[2][1], vn[2][2], vn[2][3], vn[3][0], vn[3][1], vn[3][2], vn[3][3]);
                f32x4v el[4];
#pragma unroll
                for (int t4 = 0; t4 < 4; ++t4) el[t4] = *(const LAS f32x4v*)(ELb + 4 * (16 * t4 + 4 * g));
                vs0 = pack8(vn[0][0] * el[0][0], vn[0][1] * el[0][1], vn[0][2] * el[0][2], vn[0][3] * el[0][3], vn[1][0] * el[1][0], vn[1][1] * el[1][1], vn[1][2] * el[1][2], vn[1][3] * el[1][3]);
                vs1 = pack8(vn[2][0] * el[2][0], vn[2][1] * el[2][1], vn[2][2] * el[2][2], vn[2][3] * el[2][3], vn[3][0] * el[3][0], vn[3][1] * el[3][1], vn[3][2] * el[3][2], vn[3][3] * el[3][3]);
            }
        }
        CDN_IDS();
        if (wave < 4 && it >= 1) {
            {   const int n = it - 1;
                const LAS unsigned char* Qb = lds + QS2 + q * 9216; const LAS unsigned char* Ab = lds + AS2 + q * 9216; const LAS unsigned char* EGb = lds + EG2 + q * 256;
                const int c = dir ? 31 - n : n;
#pragma unroll
                for (int t4 = 0; t4 < 4; ++t4) {
                    const LAS unsigned char* qp = Qb + (16 * t4 + l15) * P + 8 * g; const LAS unsigned char* ap = Ab + (4 * g + (l15 >> 2)) * P + (16 * t4 + 4 * (l15 & 3)) * 2;
                    f32x4v acc = (f32x4v){0.f, 0.f, 0.f, 0.f};
                    acc = MFMA16(Sb0, ld44(qp, qp + 32), acc);
                    acc = MFMA16(Sb1, ld44(qp + 64, qp + 96), acc);
                    const float egi = *(const LAS float*)(EGb + 4 * (16 * t4 + l15));
                    acc = acc * egi;
                    acc = MFMA16(vb0, cat4(vtr(ap), vtr(ap + 16 * P)), acc);
                    acc = MFMA16(vb1, cat4(vtr(ap + 32 * P), vtr(ap + 48 * P)), acc);
                    {   const int i = 16 * t4 + l15; const size_t tok = rowbase + 64 * c + (dir ? 63 - i : i);
                        *(unsigned long long*)(OUT + tok * opitch + 16 * wave + 4 * g) = (unsigned long long)cvtpk(acc[0], acc[1]) | ((unsigned long long)cvtpk(acc[2], acc[3]) << 32); }
                }
            }
            const LAS unsigned char* Kb = lds + KS2 + q * 9216; const float egL = *(const LAS float*)(lds + EG2 + q * 256 + 4 * 63);
#pragma unroll
            for (int t = 0; t < 4; ++t) {
                const LAS unsigned char* kp = Kb + (4 * g + (l15 >> 2)) * P + (16 * t + 4 * (l15 & 3)) * 2;
                f32x4v acc = St[t] * egL;
                acc = MFMA16(cat4(vtr(kp), vtr(kp + 16 * P)), vs0, acc);
                acc = MFMA16(cat4(vtr(kp + 32 * P), vtr(kp + 48 * P)), vs1, acc);
                St[t] = acc;
            }
        }
        if (it < 32 && (wave == 4 || wave == 5)) {
            const int B = wave - 4;
            {
                float x[16];
                const LAS float* mf = (const LAS float*)(lds + MF1) + B * 1024 + (g & 1) * (16 * 32 + 16);
                f32x4v mq[36];
#pragma unroll
                for (int r = 1; r < 16; ++r)
#pragma unroll
                    for (int k4 = 0; k4 * 4 < r; ++k4) mq[sub_qoff(r) + k4] = *(const LAS f32x4v*)(mf + r * 32 + 4 * k4);
                asm volatile("s_waitcnt lgkmcnt(0)" ::: "memory");
#define CDN_FNMA(a, mm, xx) asm("v_fma_f32 %0, -%1, %2, %0" : "+v"(a) : "v"(mm), "v"(xx))
#pragma unroll
                for (int r = 0; r < 16; ++r) {
                    float a0 = (r == l15) ? 1.f : 0.f, a1 = 0.f, a2 = 0.f, a3 = 0.f;
#pragma unroll
                    for (int k4 = 0; k4 * 4 < r; ++k4) { const f32x4v mr = mq[sub_qoff(r) + k4];
                        if (4 * k4 + 0 < r) CDN_FNMA(a0, mr[0], x[4 * k4 + 0]); if (4 * k4 + 1 < r) CDN_FNMA(a1, mr[1], x[4 * k4 + 1]); if (4 * k4 + 2 < r) CDN_FNMA(a2, mr[2], x[4 * k4 + 2]); if (4 * k4 + 3 < r) CDN_FNMA(a3, mr[3], x[4 * k4 + 3]); }
                    x[r] = (a0 + a1) + (a2 + a3);
                }
#undef CDN_FNMA
                const int jc0 = 32 * B + (lane & 31); const float eg0 = *(const LAS float*)(lds + EG2 + p * 256 + 4 * jc0);
                const bool up = lane >= 32;
#pragma unroll
                for (int r8 = 0; r8 < 8; ++r8) { const float xv = up ? x[8 + r8] : x[r8]; const int i = 32 * B + 16 * (g & 1) + (up ? 8 : 0) + r8;
                    st_bf2(lds + TS1 + i * P + 2 * jc0, lds + TES1 + i * P + 2 * jc0, xv, xv * eg0); }
            }
            const bool valid = r32 < 16;
            f32x16 zero;
#pragma unroll
            for (int r = 0; r < 16; ++r) zero[r] = 0.f;
            bf16x8 af = ld8(lds + MS1 + (32 * B + 16 + l15) * P + (32 * B + 8 * hi) * 2);
            if (!valid) af = (bf16x8){0, 0, 0, 0, 0, 0, 0, 0};
            const LAS unsigned char* tp = lds + TS1 + (32 * B + 8 * hi + (l15 >> 2)) * P + (32 * B + 16 * ((lane >> 4) & 1) + 4 * (lane & 3)) * 2;
            const bf16x8 bf = cat4(vtr(tp), vtr(tp + 4 * P));
            const f32x16 X = MFMA32(af, bf, zero);
            const LAS unsigned char* t11 = lds + TS1 + (32 * B + 16 + l15) * P + (32 * B + 16 + 4 * hi) * 2;
            bf16x8 a2 = ld44(t11, t11 + 16);
            if (!valid) a2 = (bf16x8){0, 0, 0, 0, 0, 0, 0, 0};
            const f32x16 Y = MFMA32(pack8(X[0], X[1], X[2], X[3], X[4], X[5], X[6], X[7]), a2, zero);
            if (valid) {
                const int i = 32 * B + 16 + l15;
#pragma unroll
                for (int h2 = 0; h2 < 2; ++h2) {
                    const int jc0 = 32 * B + 8 * h2 + 4 * hi; const f32x4v egj = *(const LAS f32x4v*)(lds + EG2 + p * 256 + 4 * jc0);
                    const float y0 = -Y[4 * h2 + 0], y1 = -Y[4 * h2 + 1], y2 = -Y[4 * h2 + 2], y3 = -Y[4 * h2 + 3];
                    *(LAS unsigned long long*)(lds + TS1 + i * P + 2 * jc0) = (unsigned long long)cvtpk(y0, y1) | ((unsigned long long)cvtpk(y2, y3) << 32);
                    *(LAS unsigned long long*)(lds + TES1 + i * P + 2 * jc0) = (unsigned long long)cvtpk(y0 * egj[0], y1 * egj[1]) | ((unsigned long long)cvtpk(y2 * egj[2], y3 * egj[3]) << 32);
                }
            }
        }
        CDN_IDS();
        if (it < 32 && wave < 3) {
                const int I = wave > 0, J = wave > 1;
                f32x16 acc;
#pragma unroll
                for (int r = 0; r < 16; ++r) acc[r] = 0.f;
                const LAS unsigned char* ap = lds + QS2 + p * 9216 + (32 * I + r32) * P + 16 * hi; const LAS unsigned char* bp = lds + KS2 + p * 9216 + (32 * J + r32) * P + 16 * hi;
#pragma unroll
                for (int s = 0; s < 4; ++s) acc = MFMA32(ld8(ap + 32 * s), ld8(bp + 32 * s), acc);
                const int j = 32 * J + r32; const float gcj = *(const LAS float*)(lds + GC2 + p * 256 + 4 * j);
#pragma unroll
                for (int q4 = 0; q4 < 4; ++q4) {
                    const int i0 = 32 * I + 8 * q4 + 4 * hi; const f32x4v gci = *(const LAS f32x4v*)(lds + GC2 + p * 256 + 4 * i0);
                    float av[4];
#pragma unroll
                    for (int e = 0; e < 4; ++e) { const int i = i0 + e; av[e] = (i >= j) ? acc[4 * q4 + e] * __builtin_amdgcn_exp2f(gci[e] - gcj) : 0.f; }
                    *(LAS unsigned long long*)(lds + AS2 + p * 9216 + j * P + 2 * i0) = (unsigned long long)cvtpk(av[0], av[1]) | ((unsigned long long)cvtpk(av[2], av[3]) << 32);
                }
            }
        __syncthreads();
        CDN_IDS();
        if (it + 1 < 32) { CDN_STAGE(q); if (it + 2 < 32) CDN_PREFETCH(it + 2); }
        if (it < 32 && wave >= 4) {
            const int ct = wave - 4; const int R = ct < 2 ? VS2 + p * 9216 : KS2 + p * 9216, coff = 32 * (ct & 1), TA = ct < 2 ? TS1 : TES1;
            const LAS unsigned char* rp = lds + R + (8 * hi + (l15 >> 2)) * P + (coff + 16 * ((lane >> 4) & 1) + 4 * (lane & 3)) * 2;
            f32x16 X0, Y, Z;
#pragma unroll
            for (int r = 0; r < 16; ++r) { X0[r] = 0.f; Y[r] = 0.f; Z[r] = 0.f; }
#pragma unroll
            for (int s = 0; s < 2; ++s) X0 = MFMA32(ld8(lds + TA + r32 * P + (16 * s + 8 * hi) * 2), cat4(vtr(rp + 16 * s * P), vtr(rp + (16 * s + 4) * P)), X0);
#pragma unroll
            for (int s = 0; s < 2; ++s) Z = MFMA32(ld8(lds + TA + (32 + r32) * P + (32 + 16 * s + 8 * hi) * 2), cat4(vtr(rp + (32 + 16 * s) * P), vtr(rp + (32 + 16 * s + 4) * P)), Z);
            { const LAS unsigned char* mp = lds + MS1 + (32 + r32) * P + 8 * hi;
              Y = MFMA32(ld44(mp, mp + 16), pack8(X0[0], X0[1], X0[2], X0[3], X0[4], X0[5], X0[6], X0[7]), Y);
              Y = MFMA32(ld44(mp + 32, mp + 48), pack8(X0[8], X0[9], X0[10], X0[11], X0[12], X0[13], X0[14], X0[15]), Y); }
            { const LAS unsigned char* t1 = lds + TS1 + (32 + r32) * P + 64 + 8 * hi;
              Z = MFMA32(ld44(t1, t1 + 16), pack8(-Y[0], -Y[1], -Y[2], -Y[3], -Y[4], -Y[5], -Y[6], -Y[7]), Z);
              Z = MFMA32(ld44(t1 + 32, t1 + 48), pack8(-Y[8], -Y[9], -Y[10], -Y[11], -Y[12], -Y[13], -Y[14], -Y[15]), Z); }
            const int col = coff + r32;
#pragma unroll
            for (int half = 0; half < 2; ++half)
#pragma unroll
                for (int q4 = 0; q4 < 4; ++q4) {
                    const int i0 = 32 * half + 8 * q4 + 4 * hi; const f32x4v bi = *(const LAS f32x4v*)(lds + BETA2 + p * 256 + 4 * i0);
                    f32x4v v;
#pragma unroll
                    for (int e = 0; e < 4; ++e) v[e] = (half ? Z[4 * q4 + e] : X0[4 * q4 + e]) * bi[e];
                    if (ct < 2) *(LAS unsigned long long*)(lds + US2 + p * 64 * UPB + col * UPB + 2 * i0) = (unsigned long long)cvtpk(v[0], v[1]) | ((unsigned long long)cvtpk(v[2], v[3]) << 32);
                    else *(LAS unsigned long long*)(lds + WS2 + p * 9216 + col * P + 2 * i0) = (unsigned long long)cvtpk(v[0], v[1]) | ((unsigned long long)cvtpk(v[2], v[3]) << 32);
                }
        }
        __syncthreads();
    }
#undef CDN_PREFETCH
#undef CDN_STAGE
#undef CDN_IDS
}

__device__ __forceinline__ void finalize_bc(int gtid, int nthreads, unsigned char* ws, unsigned char* xs, const float* outg, bf16* OBb, bf16* OBc, int opitch) {
    bf16* QO = (bf16*)(ws + WS_QO);
    const bf16 *P0 = (const bf16*)(ws + WS_P0), *P1 = (const bf16*)(ws + WS_P1), *P2 = (const bf16*)(ws + WS_P2);
    const float *L0 = (const float*)(xs + XS_L0), *L1 = (const float*)(xs + XS_L1), *L2 = (const float*)(xs + XS_L2);
    const bf16 *CF = (const bf16*)(ws + WS_CF), *CZ = (const bf16*)(ws + WS_CZ);
    constexpr int UN = 3;
    static_assert((MT * 48) % UN == 0, "finalize");
#pragma unroll 1
    for (int i0 = gtid; i0 < MT * 48; i0 += UN * nthreads) {
        v4u a[UN], bq[UN], c[UN], f[UN], bw[UN], z[UN]; float l[UN];
#pragma unroll
        for (int k = 0; k < UN; ++k) { const int i = i0 + k * nthreads; const bool ok = i < MT * 48; const int ii = ok ? i : gtid; const int row = ii / 48, c8 = ii % 48, h = c8 >> 3;
            l[k] = L0[(size_t)row * 6 + h] + L1[(size_t)row * 6 + h] + L2[(size_t)row * 6 + h];
            a[k] = *(const v4u*)(P0 + (size_t)row * 384 + c8 * 8); bq[k] = *(const v4u*)(P1 + (size_t)row * 384 + c8 * 8); c[k] = *(const v4u*)(P2 + (size_t)row * 384 + c8 * 8);
            f[k] = *(const v4u*)(CF + (size_t)row * 384 + c8 * 8); bw[k] = *(const v4u*)(QO + (size_t)row * 1024 + 640 + c8 * 8); z[k] = *(const v4u*)(CZ + (size_t)row * 384 + c8 * 8); }
#pragma unroll
        for (int k = 0; k < UN; ++k) { const int i = i0 + k * nthreads; const bool ok = i < MT * 48; const int ii = ok ? i : gtid; const int row = ii / 48, c8 = ii % 48;
            {
                const float rl = 1.0f / l[k]; v4u o;
#pragma unroll
                for (int e = 0; e < 4; ++e) {
                    const float lo = (__builtin_bit_cast(float, a[k][e] << 16) + __builtin_bit_cast(float, bq[k][e] << 16) + __builtin_bit_cast(float, c[k][e] << 16)) * rl;
                    const float hi2 = (__builtin_bit_cast(float, a[k][e] & 0xffff0000u) + __builtin_bit_cast(float, bq[k][e] & 0xffff0000u) + __builtin_bit_cast(float, c[k][e] & 0xffff0000u)) * rl;
                    o[e] = pk2(lo, hi2);
                }
                if (ok) *(v4u*)(OBb + (size_t)row * opitch + c8 * 8) = o;
            }
            {
                float t[8]; float ss = 0.f;
#pragma unroll
                for (int e = 0; e < 4; ++e) { t[2 * e] = __builtin_bit_cast(float, f[k][e] << 16) + __builtin_bit_cast(float, bw[k][e] << 16); t[2 * e + 1] = __builtin_bit_cast(float, f[k][e] & 0xffff0000u) + __builtin_bit_cast(float, bw[k][e] & 0xffff0000u);
                    ss += t[2 * e] * t[2 * e] + t[2 * e + 1] * t[2 * e + 1]; }
                ss += __shfl_xor(ss, 1); ss += __shfl_xor(ss, 2); ss += __shfl_xor(ss, 4);
                const float rs = __builtin_amdgcn_rsqf(ss * (1.0f / 64.0f) + 1e-6f);
                const float* gp = outg + (c8 & 7) * 8;
                v4u o;
#pragma unroll
                for (int e = 0; e < 4; ++e) o[e] = pk2(t[2 * e] * rs * gp[2 * e] * __builtin_bit_cast(float, z[k][e] << 16), t[2 * e + 1] * rs * gp[2 * e + 1] * __builtin_bit_cast(float, z[k][e] & 0xffff0000u));
                if (ok) *(v4u*)(OBc + (size_t)row * opitch + c8 * 8) = o;
            }
        }
    }
}
}
#define XB_TMO      128
#define XB_XCNT(j)  (256  + 64 * (j))
#define XB_XSUB(j)  (1280 + 64 * (j))
#define XB_XGEN(j)  (2304 + 64 * (j))
#define XB_TOP      3328
#define XB_TOPGEN   3392
#define XCD_BAR_WORDS 3456
#define XB_SPIN_CAP (1u << 24)

__device__ __forceinline__ unsigned xb_ld(unsigned* p)              { return __hip_atomic_load(p, __ATOMIC_RELAXED, __HIP_MEMORY_SCOPE_AGENT); }
__device__ __forceinline__ unsigned xb_add(unsigned* p, unsigned v) { return __hip_atomic_fetch_add(p, v, __ATOMIC_RELAXED, __HIP_MEMORY_SCOPE_AGENT); }
__device__ __forceinline__ unsigned xb_xcc_id() { return (unsigned)__builtin_amdgcn_s_getreg((3 << 11) | 20) & 0xFu; }
#define XB_SPIN(cond, bar) do { unsigned _sp = 0; while (cond) { __builtin_amdgcn_s_sleep(1); \
    if ((++_sp & 255u) == 0u) { if (xb_ld(&(bar)[XB_TMO])) break; if (_sp > XB_SPIN_CAP) { atomicAdd(&(bar)[XB_TMO], 1u); break; } } } } while (0)

struct XcdBarrier {
    unsigned* bar; unsigned x;
    volatile LAS unsigned* st;
};

__device__ __forceinline__ XcdBarrier xcd_barrier_post(unsigned* bar, volatile LAS unsigned* st) {
    XcdBarrier b; b.bar = bar; b.x = xb_xcc_id(); b.st = st;
    if (threadIdx.x == 0) (void)xb_add(&bar[XB_XCNT(b.x)], 1u);
    return b;
}
__device__ __forceinline__ void xcd_barrier_complete(unsigned* bar, unsigned x, unsigned& nloc, unsigned& nx) {
    const unsigned G = gridDim.x * gridDim.y * gridDim.z;
    unsigned sum, cnt, mine, sp = 0u;
    for (;;) {
        sum = 0u; cnt = 0u; mine = 0u;
#pragma unroll
        for (unsigned j = 0; j < 16; ++j) { const unsigned c = xb_ld(&bar[XB_XCNT(j)]); sum += c; cnt += (c > 0u) ? 1u : 0u; mine = (j == x) ? c : mine; }
        if (sum == G) break;
        __builtin_amdgcn_s_sleep(1);
        if ((++sp & 255u) == 0u) { if (xb_ld(&bar[XB_TMO])) break; if (sp > XB_SPIN_CAP) { atomicAdd(&bar[XB_TMO], 1u); break; } }
    }
    nloc = mine > 0u ? mine : 1u; nx = cnt > 0u ? cnt : 1u;
}

__device__ __forceinline__ void xcd_barrier(const XcdBarrier& b) {
    asm volatile("s_waitcnt vmcnt(0)" ::: "memory");
    __syncthreads();
    if (threadIdx.x == 0) {
        unsigned* bar = b.bar;
        __builtin_amdgcn_s_waitcnt(0);
        unsigned nloc = b.st[0], nx = b.st[1];
        if (nloc == 0u) { xcd_barrier_complete(bar, b.x, nloc, nx); b.st[0] = nloc; b.st[1] = nx; }
        const unsigned old = xb_add(&bar[XB_XSUB(b.x)], 1u);
        const unsigned gen = old / nloc;
        if (old + 1u == (gen + 1u) * nloc) {
            __builtin_amdgcn_fence(__ATOMIC_RELEASE, "agent");
            asm volatile("s_waitcnt vmcnt(0)" ::: "memory");
            const unsigned og = xb_add(&bar[XB_TOP], 1u);
            const unsigned tg = og / nx;
            if (og + 1u == (tg + 1u) * nx) xb_add(&bar[XB_TOPGEN], 1u);
            else XB_SPIN(xb_ld(&bar[XB_TOPGEN]) == tg, bar);
            __builtin_amdgcn_fence(__ATOMIC_ACQUIRE, "agent");
            xb_add(&bar[XB_XGEN(b.x)], 1u);
            asm volatile("s_waitcnt vmcnt(0)" ::: "memory");
        } else {
            XB_SPIN(xb_ld(&bar[XB_XGEN(b.x)]) == gen, bar);
            __builtin_amdgcn_fence(__ATOMIC_ACQUIRE, "agent");
            asm volatile("s_waitcnt vmcnt(0)" ::: "memory");
        }
    }
    __syncthreads();
}
constexpr int RING_BYTES = 139264, LDSCTL_OFF = RING_BYTES, MISC_OFF = LDSCTL_OFF + 320, LDS_BYTES = 147456;
constexpr int CW_TMO = 0, CW_BAR = 4096;
typedef GAS unsigned gu32;
#define RLX_AGENT __ATOMIC_RELAXED, __HIP_MEMORY_SCOPE_AGENT
#ifndef PROBE_MASK
#define PROBE_MASK 0
#endif
constexpr int popc9(int m) { int c = 0; for (int k = 0; k < 9; ++k) c += (m >> k) & 1; return c; }
constexpr int PH_PER_LAYER = 9 + popc9(PROBE_MASK), NPHASE = 1 + PH_PER_LAYER * DEPTH;
__device__ __forceinline__ int dup_at(int p) { int q = 0; for (int k = 0; k < 9; ++k) { const int n = 1 + ((PROBE_MASK >> k) & 1); if (p < q + n) return p - q; q += n; } return 0; }
#ifndef PROBE_SUB
#define PROBE_SUB 0
#endif
__device__ __forceinline__ int kind_at(int p) { int q = 0; for (int k = 0; k < 9; ++k) { const int n = 1 + ((PROBE_MASK >> k) & 1); if (p < q + n) return k; q += n; } return 8; }

constexpr int CW_DEP = 32768;
template <class F> __device__ __forceinline__ void units_of(int kind, int G, int bid, F f) {
    pg8::Unit u;
    if (kind == 0 || kind == 7) { pg8::SplitOrder S; S.init(MT, NGU, G, bid); for (int i = 0; S.next(i, u); ++i) f(u); }
    else { pg8::StaticOrder S; S.init(MT, kind == 2 ? NIN_MAIN : DM, G, bid); for (int i = 0; S.next(i, u); ++i) f(u); }
}
__device__ __forceinline__ int mk_lane_id() { int l; asm volatile("v_mbcnt_lo_u32_b32 %0, -1, 0\n\tv_mbcnt_hi_u32_b32 %0, -1, %0" : "=v"(l)); return l; }
__global__ void __launch_bounds__(512, 2) mk_fwd(MKArgs a) {
    extern __shared__ __attribute__((aligned(16))) unsigned char lds_raw[];
    LAS unsigned char* lds = (LAS unsigned char*)lds_raw;
    volatile LAS unsigned* MISC = (volatile LAS unsigned*)(lds + MISC_OFF);
    const int tid0 = threadIdx.x;
    const int wave0 = __builtin_amdgcn_readfirstlane(tid0 >> 6);
    const int G = gridDim.x;
    unsigned char* ws = a.ws;
    for (int u = tid0; u < (LDS_BYTES - LDSCTL_OFF) / 4; u += 512) ((LAS unsigned*)(lds + LDSCTL_OFF))[u] = 0u;
    __syncthreads();
    const int lo = a.ph_lo, hi = a.ph_hi;
    XcdBarrier bar = xcd_barrier_post((unsigned*)(ws + WS_CTL) + CW_BAR + lo * 4096, MISC + 8);
    unsigned dep_target = 0u;
#pragma unroll 1
    for (int ph = lo; ph < hi; ++ph) {
#define MK_TID() (wave0 * 64 + mk_lane_id())
        const int wave = wave0;
        int bid = blockIdx.x; asm volatile("" : "+s"(bid));
        const int l = ph == 0 ? 0 : (ph - 1) / PH_PER_LAYER, kind = ph == 0 ? -1 : kind_at((ph - 1) % PH_PER_LAYER);
        bf16* HB = (bf16*)(ws + WS_HB); bf16* HID = (bf16*)(ws + WS_HID);
        unsigned char* wl = ws + WS_W + (size_t)l * W_LAYER;
        const float* pb = (const float*)(ws + WS_PB) + l * PB_LAYER;
        if (kind == -1) {
#ifndef PROBE_PRO
#define PROBE_PRO 0
#endif
#pragma unroll 1
            for (int rep = 0; rep <= PROBE_PRO; ++rep)
            prologue_phase((const CAS cfp*)__builtin_amdgcn_kernarg_segment_ptr(), ws, lds, bid * 8 + wave, G * 8, wave, mk_lane_id());
        } else if (kind == 0 || kind == 7) {
            pg8::Gemm g{HB, (const bf16*)(wl + (kind ? OFF_GU2 : OFF_GU1)), MT, NGU, DM}; pg8::SplitOrder S; S.init(MT, NGU, G, bid);
            pg8::EpiSwiGLU E{ws, DFF, 0}; E.tbl = pg8::fill_rstd(lds, S, (const float*)(ws + WS_SSQ), MK_TID(), 8);
            pg8::gemm_phase<pg8::EpiSwiGLU, pg8::SplitOrder, true, true, true>(lds, g, S, E, MK_TID());
        } else if (kind == 1 || kind == 8) {
            pg8::Gemm g{HID, (const bf16*)(wl + (kind == 8 ? OFF_D2 : OFF_D1)), MT, DM, DFF}; pg8::StaticOrder S; S.init(MT, DM, G, bid);
            pg8::EpiResid E{(l == 0 && kind == 1) ? a.in[0] : nullptr, (l == DEPTH - 1 && kind == 8) ? a.out : nullptr, ws, 0.5f, 0};
            pg8::gemm_phase<pg8::EpiResid, pg8::StaticOrder, true, true>(lds, g, S, E, MK_TID());
        } else if (kind == 2) {
            pg8::Gemm g{HB, (const bf16*)(wl + OFF_IN), MT, NIN_MAIN, DM}; pg8::StaticOrder S; S.init(MT, NIN_MAIN, G, bid);
            pg8::EpiInProj E{ws, l, 0, 0}; pg8::fill_params<int>(lds, pb, MK_TID()); E.tbl = pg8::fill_rstd(lds, S, (const float*)(ws + WS_SSQ), MK_TID(), 6);
            pg8::gemm_phase<pg8::EpiInProj, pg8::StaticOrder, true, true>(lds, g, S, E, MK_TID());
        } else if (kind == 3) {
#pragma unroll 1
            for (int it = bid * 8 + wave; it < 256 * 18; it += G * 8) cdn::prep_item(it, mk_lane_id(), ws, (unsigned char*)a.out, pb + PB_CONV);
            if (l == 0) {   const float refA = pb[PB_REFA];
#pragma unroll 1
                for (int ia = bid; ia < 256; ia += G) att::itemA(lds, ia, MK_TID(), ws, refA, (bf16*)(ws + WS_QO), 1024);
            }
        } else if (kind == 4) {
            const float refB = pb[PB_REFB]; const float* tbg = (const float*)(ws + WS_PB) + PB_TB;
            const int isdup = dup_at((ph - 1) % PH_PER_LAYER); const bool do_scan = !(isdup && PROBE_SUB == 2), do_b = !(isdup && PROBE_SUB == 1);
            if (do_scan) {
#pragma unroll 1
            for (int it = bid; it < 96; it += G) cdn::scan_item(lds, it, MK_TID(), ws, (unsigned char*)a.out);
            }
            const int nbw = G > 96 ? G - 96 : G, st = G > 96 ? bid - 96 : bid;
            const bool dynq = (G == 256) && PROBE_MASK == 0;
            if (st >= 0 && do_b) {
                {
                    pg8::Gemm g{HB, (const bf16*)(wl + OFF_IN) + (size_t)NIN_MAIN * DM, MT, 256, DM}; pg8::StaticOrder S; S.init(MT, 256, nbw > 96 ? nbw - 96 : nbw, nbw > 96 ? (st >= 96 ? st - 96 : 1 << 20) : st);
                    pg8::EpiInProj E{ws, l, 48, 0}; pg8::fill_params<int>(lds, pb, MK_TID()); E.tbl = pg8::fill_rstd(lds, S, (const float*)(ws + WS_SSQ), MK_TID(), 6);
                    pg8::gemm_phase<pg8::EpiInProj, pg8::StaticOrder, true, true>(lds, g, S, E, MK_TID());
                }
                if (l != 0) { const float refA = pb[PB_REFA];
#pragma unroll 1
                    for (int ia = st; ia < 256; ia += nbw) att::itemA(lds, ia, MK_TID(), ws, refA, (bf16*)(ws + WS_QO), 1024); }
            }
            if (do_b && (st >= 0 || dynq)) {
                att::fill_tables(lds, tbg, MK_TID());
                bf16* const Pb[3] = {(bf16*)(ws + WS_P0), (bf16*)(ws + WS_P1), (bf16*)(ws + WS_P2)};
                float* const Lb[3] = {(float*)((unsigned char*)a.out + XS_L0), (float*)((unsigned char*)a.out + XS_L1), (float*)((unsigned char*)a.out + XS_L2)};
                if (dynq) {
                    const int NA = 0, NB = NA + 768, NQ = NB + (l == 0 ? 640 : 0); const float refA = pb[PB_REFA];
                    unsigned* qctr = (unsigned*)(ws + WS_CTL) + 96 + 16 * l; volatile LAS unsigned* QW = MISC + 16;
                    unsigned nx = 0u;
                    if (MK_TID() == 0) { nx = xb_add(qctr, 1u); QW[0] = nx; }
                    __syncthreads();
                    int ib = __builtin_amdgcn_readfirstlane((int)QW[0]);
#pragma unroll 1
                    while (ib < NQ) {
                        if (MK_TID() == 0) nx = xb_add(qctr, 1u);
                        if (ib < NA) att::itemA(lds, ib, MK_TID(), ws, refA, (bf16*)(ws + WS_QO), 1024);
                        else if (ib < NB) att::itemB(lds, ib - NA, MK_TID(), ws, refB, Pb, Lb);
                        else { convert_weights((const CAS cfp*)__builtin_amdgcn_kernarg_segment_ptr(), ws, lds, (ib - NB) * 8 + wave, 640 * 8, wave, mk_lane_id(), 1); __syncthreads(); }
                        if (MK_TID() == 0) QW[0] = nx;
                        __syncthreads();
                        ib = __builtin_amdgcn_readfirstlane((int)QW[0]);
                    }
                } else {
#pragma unroll 1
                    for (int ib = st; ib < 768; ib += nbw) att::itemB(lds, ib, MK_TID(), ws, refB, Pb, Lb);
                }
            }
            if (!dynq && st >= 0 && do_b && l == 0 && dup_at((ph - 1) % PH_PER_LAYER) == 0)
                convert_weights((const CAS cfp*)__builtin_amdgcn_kernarg_segment_ptr(), ws, lds, st * 8 + wave, nbw * 8, wave, mk_lane_id(), 1);
        } else if (kind == 5) {
            const bool scr5 = (PROBE_MASK & 32) && dup_at((ph - 1) % PH_PER_LAYER) == 0;
            cdn::finalize_bc(bid * 512 + MK_TID(), G * 512, ws, (unsigned char*)a.out, pb + PB_OUTG, scr5 ? (bf16*)(ws + WS_VC) : (bf16*)(ws + WS_QO) + 256, scr5 ? (bf16*)(ws + WS_VC) : (bf16*)(ws + WS_QO) + 640, scr5 ? 384 : 1024);
        } else {
            pg8::Gemm g{(const bf16*)(ws + WS_QO), (const bf16*)(wl + OFF_O), MT, DM, DM}; pg8::StaticOrder S; S.init(MT, DM, G, bid);
            pg8::EpiResid E{nullptr, nullptr, ws, 1.0f, 0};
            pg8::gemm_phase<pg8::EpiResid, pg8::StaticOrder, true, true>(lds, g, S, E, MK_TID());
        }
        if (ph + 1 < hi) {
            const int kn = kind_at(ph % PH_PER_LAYER);
            const bool chain = (kind == 0 && kn == 1) || (kind == 1 && kn == 2) || (kind == 6 && kn == 7) || (kind == 7 && kn == 8) || (kind == 8 && kn == 0);
            if (chain) {
                dep_target += (kind == 0 || kind == 7) ? 2u * (NGU / 256) : 2u * (DM / 256);
                asm volatile("s_waitcnt vmcnt(0)" ::: "memory");
                __syncthreads();
                if (MK_TID() == 0) {
                    unsigned* dep = (unsigned*)(ws + WS_CTL) + CW_DEP; unsigned* barw = bar.bar;
                    units_of(kind, G, bid, [&](const pg8::Unit& u) { (void)xb_add(dep + 64 * u.pm, u.hm ? 1u : 2u); });
                    const unsigned tgt = dep_target;
                    units_of(kn, G, bid, [&](const pg8::Unit& u) { XB_SPIN(xb_ld(dep + 64 * u.pm) < tgt, barw); });
                    __builtin_amdgcn_fence(__ATOMIC_ACQUIRE, "agent");
                    asm volatile("s_waitcnt vmcnt(0)" ::: "memory");
                }
                __syncthreads();
            } else xcd_barrier(bar);
        }
    }
}

extern "C" void kernel_launch(void* const* d_in, const int* in_sizes, int n_in, void* d_out, int out_size, void* d_ws, size_t ws_size, hipStream_t stream) {
    static int grid = 0;
    if (grid == 0) {
        if (n_in != 21 || out_size != MT * DM || ws_size < WS_END) { fprintf(stderr, "kernel_launch: unexpected problem shape (n_in %d out %d ws %zu)\n", n_in, out_size, ws_size); grid = -1; return; }
        int dev = 0, cus = 0, per_cu = 0;
        if (hipGetDevice(&dev) != hipSuccess || hipDeviceGetAttribute(&cus, hipDeviceAttributeMultiprocessorCount, dev) != hipSuccess) { grid = -1; return; }
        if (hipFuncSetAttribute((const void*)mk_fwd, hipFuncAttributeMaxDynamicSharedMemorySize, LDS_BYTES) != hipSuccess) { fprintf(stderr, "kernel_launch: hipFuncSetAttribute failed\n"); grid = -1; return; }
        if (hipOccupancyMaxActiveBlocksPerMultiprocessor(&per_cu, (const void*)mk_fwd, 512, LDS_BYTES) != hipSuccess || per_cu < 1) { fprintf(stderr, "kernel_launch: occupancy query says %d\n", per_cu); per_cu = 1; }
        (void)hipGetLastError();
        grid = cus;
    }
    if (grid < 0) return;
    (void)hipMemsetAsync((char*)d_ws + WS_CTL, 0, WS_PB, stream);
    MKArgs a; memset(&a, 0, sizeof a);
    for (int i = 0; i < 21; ++i) a.in[i] = (const float*)d_in[i];
    a.out = (float*)d_out; a.ws = (unsigned char*)d_ws;
    a.ph_lo = 0; a.ph_hi = NPHASE;
    hipLaunchKernelGGL(mk_fwd, dim3(grid), dim3(512), LDS_BYTES, stream, a);
}
```
